# Optimizing an MI355X kernel written in HIP

```python
import jax, jax.numpy as jnp
from jax import lax
import numpy as np

D_MODEL = 1024
BATCH = 8
SEQ = 2048
DEPTH = 1

CONV_GROUPS = 16
CONV_GROUP_DIM = 64
D_CONV = CONV_GROUPS * CONV_GROUP_DIM
CONV_WIDTH = 3
N_Q_HEADS = 16
N_KV_HEADS = 2
HEAD_DIM = 64
Q_PER_KV = N_Q_HEADS // N_KV_HEADS
D_ATTN = N_Q_HEADS * HEAD_DIM
D_KV = N_KV_HEADS * HEAD_DIM
WINDOW = 128
BLOCK = 128
D_MIX = D_CONV + D_ATTN
D_IN_PROJ = 4 * D_CONV + 2 * D_ATTN + 2 * D_KV
SPLIT_POINTS = (D_CONV, 2 * D_CONV, 3 * D_CONV, 4 * D_CONV,
                4 * D_CONV + D_ATTN,
                4 * D_CONV + D_ATTN + D_KV,
                4 * D_CONV + D_ATTN + 2 * D_KV)
RMS_EPS = 1e-5

kernel_name = "hybrid_shortconv_swa_sink_alibi_parallel"


def rms_norm(x, gain):
    xf = x.astype(jnp.float32)
    y = xf * lax.rsqrt(jnp.mean(xf * xf, axis=-1, keepdims=True) + RMS_EPS)
    return (y * gain.astype(jnp.float32)).astype(x.dtype)


def alibi_slopes(n_heads):
    return jnp.exp2(-8.0 * jnp.arange(1, n_heads + 1, dtype=jnp.float32) / n_heads)


def short_conv(u, w):
    k = w[:, None, :].astype(u.dtype)
    return lax.conv_general_dilated(
        u, k, window_strides=(1,), padding=[(CONV_WIDTH - 1, 0)],
        dimension_numbers=("NWC", "WIO", "NWC"), feature_group_count=u.shape[-1])


def sliding_window_attention(q, k, v, sinks):
    bsz, seq, _ = q.shape
    nb = seq // BLOCK
    q = q.reshape(bsz, nb, BLOCK, N_KV_HEADS, Q_PER_KV, HEAD_DIM)
    k = k.reshape(bsz, nb, BLOCK, N_KV_HEADS, HEAD_DIM)
    v = v.reshape(bsz, nb, BLOCK, N_KV_HEADS, HEAD_DIM)
    pad = ((0, 0), (1, 0), (0, 0), (0, 0), (0, 0))
    k_band = jnp.concatenate([jnp.pad(k, pad)[:, :-1], k], axis=2)
    v_band = jnp.concatenate([jnp.pad(v, pad)[:, :-1], v], axis=2)
    scores = jnp.einsum("bnqhgd,bnkhd->bnhgqk", q, k_band).astype(jnp.float32)
    scores = scores * (HEAD_DIM ** -0.5)
    qi = jnp.arange(BLOCK)
    kj = jnp.arange(2 * BLOCK)
    dist = BLOCK + qi[:, None] - kj[None, :]
    key_pos = jnp.arange(nb)[:, None] * BLOCK - BLOCK + kj[None, :]
    valid = ((dist >= 0) & (dist < WINDOW))[None, :, :] & (key_pos >= 0)[:, None, :]
    slopes = alibi_slopes(N_Q_HEADS).reshape(N_KV_HEADS, Q_PER_KV)
    alibi = -slopes[:, :, None, None] * dist.astype(jnp.float32)
    scores = jnp.where(valid[None, :, None, None], scores + alibi[None, None], -jnp.inf)
    sink = sinks.astype(jnp.float32).reshape(N_KV_HEADS, Q_PER_KV)[None, None, :, :, None, None]
    m = jnp.maximum(jnp.max(scores, axis=-1, keepdims=True), sink)
    p = jnp.exp(scores - m)
    denom = jnp.sum(p, axis=-1, keepdims=True) + jnp.exp(sink - m)
    probs = (p / denom).astype(v.dtype)
    out = jnp.einsum("bnhgqk,bnkhd->bnqhgd", probs, v_band)
    return out.reshape(bsz, seq, D_ATTN)


def setup_inputs(seed: int = 0) -> dict:
    key = jax.random.key(seed)
    ks = jax.random.split(key, 10)
    f32 = jnp.float32
    x = jax.random.normal(ks[0], (BATCH, SEQ, D_MODEL), f32)
    norm_in = 1.0 + 0.1 * jax.random.normal(ks[1], (DEPTH, D_MODEL), f32)
    w_in = jax.random.normal(ks[2], (DEPTH, D_MODEL, D_IN_PROJ), f32) * D_MODEL ** -0.5
    conv_w = jax.random.normal(ks[3], (DEPTH, CONV_WIDTH, D_CONV), f32) * CONV_WIDTH ** -0.5
    attn_sinks = jax.random.normal(ks[4], (DEPTH, N_Q_HEADS), f32)
    norm_conv_out = 1.0 + 0.1 * jax.random.normal(ks[5], (DEPTH, D_CONV), f32)
    norm_attn_out = 1.0 + 0.1 * jax.random.normal(ks[6], (DEPTH, D_ATTN), f32)
    w_out = jax.random.normal(ks[7], (DEPTH, D_MIX, D_MODEL), f32) * D_MIX ** -0.5
    norm_final = 1.0 + 0.1 * jax.random.normal(ks[8], (D_MODEL,), f32)
    return {"x": x, "norm_in": norm_in, "w_in": w_in, "conv_w": conv_w,
            "attn_sinks": attn_sinks, "norm_conv_out": norm_conv_out,
            "norm_attn_out": norm_attn_out, "w_out": w_out, "norm_final": norm_final}


def reference(x, norm_in, w_in, conv_w, attn_sinks, norm_conv_out, norm_attn_out, w_out, norm_final):
    for layer in range(DEPTH):
        h = rms_norm(x, norm_in[layer])
        proj = jnp.einsum("bsd,de->bse", h, w_in[layer])
        cb, cc, cu, gate_c, q, k, v, gate_a = jnp.split(proj, SPLIT_POINTS, axis=-1)
        conv_y = cb * short_conv(cc * cu, conv_w[layer])
        conv_y = rms_norm(conv_y, norm_conv_out[layer]) * jax.nn.silu(gate_c)
        attn_y = sliding_window_attention(q, k, v, attn_sinks[layer])
        attn_y = rms_norm(attn_y, norm_attn_out[layer]) * jax.nn.silu(gate_a)
        mixed = jnp.concatenate([conv_y, attn_y], axis=-1)
        x = x + jnp.einsum("bse,ed->bsd", mixed, w_out[layer])
    return rms_norm(x, norm_final)
```

```cpp
#include <hip/hip_runtime.h>
#include <hip/hip_cooperative_groups.h>
#include <cstdio>
#include <cstdint>
namespace cg = cooperative_groups;

#define LAS __attribute__((address_space(3)))
#define XB_TMO      128
#define XB_XCNT(j)  (256  + 64 * (j))
#define XB_XSUB(j)  (1280 + 64 * (j))
#define XB_XGEN(j)  (2304 + 64 * (j))
#define XB_TOP      3328
#define XB_TOPGEN   3392
#define XCD_BAR_WORDS 3456
#define XB_SPIN_CAP (1u << 18)

__device__ __forceinline__ unsigned xb_ld(unsigned* p)              { return __hip_atomic_load(p, __ATOMIC_RELAXED, __HIP_MEMORY_SCOPE_AGENT); }
__device__ __forceinline__ unsigned xb_add(unsigned* p, unsigned v) { return __hip_atomic_fetch_add(p, v, __ATOMIC_RELAXED, __HIP_MEMORY_SCOPE_AGENT); }
__device__ __forceinline__ unsigned xb_xcc_id() { return (unsigned)__builtin_amdgcn_s_getreg((3 << 11) | 20) & 0xFu; }
#define XB_SPIN(cond, bar) do { unsigned _sp = 0; while (cond) { __builtin_amdgcn_s_sleep(1); \
    if ((++_sp & 255u) == 0u) { if (xb_ld(&(bar)[XB_TMO])) break; if (_sp > XB_SPIN_CAP) { atomicAdd(&(bar)[XB_TMO], 1u); break; } } } } while (0)

struct XcdBarrier {
    unsigned* bar; unsigned x; unsigned total;
    volatile LAS unsigned* st;
};

__device__ __forceinline__ XcdBarrier xcd_barrier_post(unsigned* bar, volatile LAS unsigned* st, unsigned total) {
    XcdBarrier b; b.bar = bar; b.x = xb_xcc_id(); b.st = st; b.total = total;
    if (threadIdx.x == 0) (void)xb_add(&bar[XB_XCNT(b.x)], 1u);
    return b;
}
__device__ __forceinline__ void xcd_barrier_complete(unsigned* bar, unsigned x, unsigned& nloc, unsigned& nx, unsigned G) {
    unsigned sum, cnt, mine, sp = 0u;
    for (;;) {
        sum = 0u; cnt = 0u; mine = 0u;
#pragma unroll
        for (unsigned j = 0; j < 16; ++j) { const unsigned c = xb_ld(&bar[XB_XCNT(j)]); sum += c; cnt += (c > 0u) ? 1u : 0u; mine = (j == x) ? c : mine; }
        if (sum == G) break;
        __builtin_amdgcn_s_sleep(1);
        if ((++sp & 255u) == 0u) { if (xb_ld(&bar[XB_TMO])) break; if (sp > XB_SPIN_CAP) { atomicAdd(&bar[XB_TMO], 1u); break; } }
    }
    nloc = mine > 0u ? mine : 1u; nx = cnt > 0u ? cnt : 1u;
}

__device__ __forceinline__ void xcd_barrier(const XcdBarrier& b) {
    asm volatile("s_waitcnt vmcnt(0)" ::: "memory");
    __syncthreads();
    if (threadIdx.x == 0) {
        unsigned* bar = b.bar;
        __builtin_amdgcn_s_waitcnt(0);
        unsigned nloc = b.st[0], nx = b.st[1];
        if (nloc == 0u) { xcd_barrier_complete(bar, b.x, nloc, nx, b.total); b.st[0] = nloc; b.st[1] = nx; }
        const unsigned old = xb_add(&bar[XB_XSUB(b.x)], 1u);
        const unsigned gen = old / nloc;
        if (old + 1u == (gen + 1u) * nloc) {
            __builtin_amdgcn_fence(__ATOMIC_RELEASE, "agent");
            asm volatile("s_waitcnt vmcnt(0)" ::: "memory");
            const unsigned og = xb_add(&bar[XB_TOP], 1u);
            const unsigned tg = og / nx;
            if (og + 1u == (tg + 1u) * nx) xb_add(&bar[XB_TOPGEN], 1u);
            else XB_SPIN(xb_ld(&bar[XB_TOPGEN]) == tg, bar);
            __builtin_amdgcn_fence(__ATOMIC_ACQUIRE, "agent");
            xb_add(&bar[XB_XGEN(b.x)], 1u);
            asm volatile("s_waitcnt vmcnt(0)" ::: "memory");
        } else {
            XB_SPIN(xb_ld(&bar[XB_XGEN(b.x)]) == gen, bar);
            __builtin_amdgcn_fence(__ATOMIC_ACQUIRE, "agent");
            asm volatile("s_waitcnt vmcnt(0)" ::: "memory");
        }
    }
    __syncthreads();
}

typedef unsigned wt_u32x4 __attribute__((ext_vector_type(4)));
typedef float wt_f32x4 __attribute__((ext_vector_type(4)));
__device__ __forceinline__ void st_wt16(void* p, wt_u32x4 v) { asm volatile("global_store_dwordx4 %0, %1, off sc1\n\ts_nop 1" :: "v"(p), "v"(v) : "memory"); }
__device__ __forceinline__ void st_wt16f(void* p, wt_f32x4 v) { asm volatile("global_store_dwordx4 %0, %1, off sc1\n\ts_nop 1" :: "v"(p), "v"(v) : "memory"); }
namespace pg8 {
#define PG8_LAS __attribute__((address_space(3)))
typedef unsigned short bf16_t;
typedef short bf16x8 __attribute__((ext_vector_type(8)));
typedef float f32x4 __attribute__((ext_vector_type(4)));
typedef unsigned u32x4 __attribute__((ext_vector_type(4)));
constexpr int BM = 256, BK = 64, HALF = 128, HTB = HALF * BK * 2  , STAGE_BYTES = 8 * HTB, NXCD = 8, WGM = 8;

__host__ __device__ __forceinline__ int lds_byte(int r, int c) { const int st = (r >> 4) * 2 + (c >> 5), rr = r & 15, cc = c & 31, ob = rr * 64 + cc * 2; return st * 1024 + (ob ^ (((ob >> 9) & 1) << 5)); }
__host__ __device__ __forceinline__ void stage_rc(int b, int& R, int& C) { const int st = b / 1024, sb = b % 1024, swz = sb ^ (((sb >> 9) & 1) << 5); R = (st >> 1) * 16 + swz / 64; C = (st & 1) * 32 + (swz % 64) / 2; }
__host__ __device__ __forceinline__ int perm32(int rho) { const int n = rho >> 4, i = rho & 15; return 8 * (i >> 2) + 4 * n + (i & 3); }

struct Unit { int pm, pn; };
struct Gemm { const bf16_t* A; const bf16_t* Bt; int M, N, K; };

struct StaticOrder {
    int nM, nN, nwg, G, c, base, lim;
    __host__ __device__ void init(int M, int N, int G_, int c_) { nM = M / BM; nN = N / BM; nwg = nM * nN; G = G_; c = c_; base = 0; lim = nwg; }
    __host__ __device__ void window(int b, int l) { base = b; lim = l; }
    __host__ __device__ bool next(int i, Unit& u) const {
        const long L = (long)base + (long)i * G + c; if (L >= lim) return false;
        int wgid = (int)L; { const int q = nwg / NXCD, r = nwg % NXCD, xcd = wgid % NXCD, off = wgid / NXCD; wgid = (xcd < r ? xcd * (q + 1) : r * (q + 1) + (xcd - r) * q) + off; }
        const int nig = WGM * nN, gid = wgid / nig, fm = gid * WGM, gsz = (nM - fm) < WGM ? (nM - fm) : WGM;
        u.pm = fm + ((wgid % nig) % gsz); u.pn = (wgid % nig) / gsz; return true;
    }
    __device__ __forceinline__ void a_ready(const Unit&) const {}
    __device__ __forceinline__ void done(const Unit&) const {}
};

struct ArriveOrder : StaticOrder {
    unsigned* cnt; int first_pn;
    __device__ __forceinline__ void done(const Unit& u) const {
        if (cnt != nullptr && u.pn == first_pn) {
            asm volatile("s_waitcnt vmcnt(0)" ::: "memory");
            if ((threadIdx.x & 63) == 0) __hip_atomic_fetch_add(cnt, 1u, __ATOMIC_RELAXED, __HIP_MEMORY_SCOPE_AGENT);
        }
    }
};

__device__ __forceinline__ unsigned cvt_pk_bf16(float lo, float hi) { unsigned r; asm volatile("v_cvt_pk_bf16_f32 %0, %1, %2" : "=v"(r) : "v"(lo), "v"(hi)); return r; }
typedef unsigned u32x2 __attribute__((ext_vector_type(2)));
constexpr float RMS_EPS = 1e-5f;
__device__ __forceinline__ float silu_f(float g) { return g * __builtin_amdgcn_rcpf(1.0f + __builtin_amdgcn_exp2f(-1.4426950408889634f * g)); }

struct EpiInProj {
    static constexpr bool PERM = false, AFTER_DRAIN = false, MID = false, XPF = false;
    bf16_t *MIX, *QKVG; const float *conv_w, *gain_c; float *SSCT, *HALO, *DEF;
    __device__ __forceinline__ void begin(const Unit& u, PG8_LAS unsigned char* lds) const {}
    __device__ __forceinline__ void mid(f32x4 (&acc)[2][2][4][2], const Unit& u, int wr, int fr, PG8_LAS unsigned char* lds) const {}
    __device__ __forceinline__ void operator()(f32x4 (&acc)[2][2][4][2], const Unit& u, int wr, int wc, int fr, int fq, PG8_LAS unsigned char* lds) const {
        if (u.pn >= 9) {
            const int lane = threadIdx.x & 63, j = u.pn - 9, col = j * 64 + wc * 16 + fq * 4;
            PG8_LAS f32x4* XB = (PG8_LAS f32x4*)(lds + STAGE_BYTES + 2048);
#pragma unroll
            for (int ai = 0; ai < 2; ++ai)
#pragma unroll
                for (int m = 0; m < 4; ++m) acc[ai][0][m][1] *= acc[ai][1][m][0];
            if (fr >= 14) {
#pragma unroll
                for (int ai = 0; ai < 2; ++ai) XB[((2 * ai + wr) * 4 + wc) * 8 + fq * 2 + (fr - 14)] = acc[ai][0][3][1];
                if (wr == 1) st_wt16f(HALO + ((size_t)u.pm * 2 + (fr - 14)) * 1024 + col, acc[1][0][3][1]);
            }
            asm volatile("s_waitcnt lgkmcnt(0)" ::: "memory"); __builtin_amdgcn_s_barrier(); asm volatile("" ::: "memory");
            const f32x4 w0 = *(const f32x4*)(conv_w + col), w1 = *(const f32x4*)(conv_w + 1024 + col), w2 = *(const f32x4*)(conv_w + 2048 + col), gn = *(const f32x4*)(gain_c + col);
            const bool deferred_tile = (u.pm & 7) != 0;
#pragma unroll
            for (int ai = 0; ai < 2; ++ai) {
                const int g = 2 * ai + wr;
                f32x4 prev = (f32x4){0.f, 0.f, 0.f, 0.f};
                if (g >= 1) prev = XB[((g - 1) * 4 + wc) * 8 + fq * 2 + (fr & 1)];
#pragma unroll
                for (int m = 0; m < 4; ++m) {
                    const f32x4 uc = acc[ai][0][m][1], cb = acc[ai][0][m][0], gt = acc[ai][1][m][1];
                    f32x4 v1, v2;
#pragma unroll
                    for (int i = 0; i < 4; ++i) {
                        const float s1 = (fr == 15) ? prev[i] : uc[i], s2 = (fr >= 14) ? prev[i] : uc[i];
                        v1[i] = __int_as_float(__builtin_amdgcn_mov_dpp(__float_as_int(s1), 0x121, 0xf, 0xf, true));
                        v2[i] = __int_as_float(__builtin_amdgcn_mov_dpp(__float_as_int(s2), 0x122, 0xf, 0xf, true));
                    }
                    const f32x4 raw = cb * (w0 * v2 + w1 * v1 + w2 * uc);
                    float ss = (raw[0] * raw[0] + raw[1] * raw[1]) + (raw[2] * raw[2] + raw[3] * raw[3]);
                    ss += __shfl_xor(ss, 16); ss += __shfl_xor(ss, 32);
                    const int rl = ai * HALF + wr * 64 + m * 16 + fr;
                    const bool def = deferred_tile && (rl < 2);
                    if (fq == 0) SSCT[((size_t)u.pm * 64 + j * 4 + wc) * 256 + rl] = def ? 0.f : ss;
                    u32x2 z;
                    z.x = cvt_pk_bf16(raw[0] * gn[0] * silu_f(gt[0]), raw[1] * gn[1] * silu_f(gt[1]));
                    z.y = cvt_pk_bf16(raw[2] * gn[2] * silu_f(gt[2]), raw[3] * gn[3] * silu_f(gt[3]));
                    *(u32x2*)(MIX + (size_t)(u.pm * BM + rl) * 2048 + col) = z;
                    if (def) { float* d = DEF + ((size_t)(u.pm * 2 + rl) * 3) * 1024 + col; st_wt16f(d, cb); st_wt16f(d + 1024, uc); st_wt16f(d + 2048, gt); }
                    prev = uc;
                }
            }
        } else {
            const int row0 = u.pm * BM + wr * 64 + fr;
            const int col = u.pn * 256 + wc * 32 + fq * 8;
            const float qs = (u.pn < 4) ? 0.125f * 1.4426950408889634f : 1.0f;
#pragma unroll
            for (int ai = 0; ai < 2; ++ai)
#pragma unroll
                for (int m = 0; m < 4; ++m) {
                    bf16_t* rowp = QKVG + (size_t)(row0 + ai * HALF + m * 16) * 2304 + col;
#pragma unroll
                    for (int bj = 0; bj < 2; ++bj) {
                        const f32x4 v0 = acc[ai][bj][m][0] * qs, v1 = acc[ai][bj][m][1] * qs;
                        u32x4 w; w.x = cvt_pk_bf16(v0[0], v0[1]); w.y = cvt_pk_bf16(v0[2], v0[3]); w.z = cvt_pk_bf16(v1[0], v1[1]); w.w = cvt_pk_bf16(v1[2], v1[3]);
                        st_wt16(rowp + bj * HALF, w);
                    }
                }
        }
    }
};

struct EpiOut {
    static constexpr bool PERM = false, AFTER_DRAIN = false, MID = true, XPF = false;
    const float* x; float* out; const float* SSC; const float* SSA; float* SSF;
    __device__ __forceinline__ void begin(const Unit& u, PG8_LAS unsigned char* lds) const {
        if (threadIdx.x < 256) { const int row = u.pm * BM + threadIdx.x;
            const float* pc = SSC + (size_t)u.pm * 64 * 256 + threadIdx.x;
            const f32x4 av0 = *(const f32x4*)(SSA + 8 * (size_t)row), av1 = *(const f32x4*)(SSA + 8 * (size_t)row + 4);
            float pv[64];
#pragma unroll
            for (int k = 0; k < 64; ++k) pv[k] = pc[k * 256];
            float c4[4] = {0.f, 0.f, 0.f, 0.f};
#pragma unroll
            for (int k = 0; k < 64; ++k) c4[k & 3] += pv[k];
            const float c = (c4[0] + c4[1]) + (c4[2] + c4[3]);
            const f32x4 av = av0 + av1; const float a = (av[0] + av[1]) + (av[2] + av[3]);
            ((PG8_LAS float*)(lds + STAGE_BYTES))[threadIdx.x] = __builtin_amdgcn_rsqf(c * (1.0f / 1024.0f) + RMS_EPS) * __builtin_amdgcn_sqrtf(a * (1.0f / 1024.0f) + RMS_EPS); }
    }
    __device__ __forceinline__ void mid(f32x4 (&acc)[2][2][4][2], const Unit& u, int wr, int fr, PG8_LAS unsigned char* lds) const {
        const PG8_LAS float* tab = (const PG8_LAS float*)(lds + STAGE_BYTES) + wr * 64 + fr;
#pragma unroll
        for (int ai = 0; ai < 2; ++ai)
#pragma unroll
            for (int m = 0; m < 4; ++m) {
                const float s = tab[ai * HALF + m * 16];
#pragma unroll
                for (int bj = 0; bj < 2; ++bj)
#pragma unroll
                    for (int n = 0; n < 2; ++n) acc[ai][bj][m][n] *= s;
            }
    }
    __device__ __forceinline__ void operator()(f32x4 (&acc)[2][2][4][2], const Unit& u, int wr, int wc, int fr, int fq, PG8_LAS unsigned char* lds) const {
        const int col0 = u.pn * BM + wc * 32 + 4 * fq;
#pragma unroll
        for (int ai = 0; ai < 2; ++ai)
#pragma unroll
            for (int m = 0; m < 4; ++m) {
                const int row = u.pm * BM + ai * HALF + wr * 64 + m * 16 + fr;
                const f32x4 av = *(const f32x4*)(SSA + 8 * (size_t)row) + *(const f32x4*)(SSA + 8 * (size_t)row + 4); const float a = (av[0] + av[1]) + (av[2] + av[3]);
                const float ra = __builtin_amdgcn_rsqf(a * (1.0f / 1024.0f) + RMS_EPS);
                const size_t off = (size_t)row * 1024 + col0;
                float ss = 0.f;
#pragma unroll
                for (int bj = 0; bj < 2; ++bj)
#pragma unroll
                    for (int n = 0; n < 2; ++n) {
                        const f32x4 xv = *(const f32x4*)(x + off + bj * HALF + n * 16);
                        const f32x4 y = xv + acc[ai][bj][m][n] * ra;
                        *(f32x4*)(out + off + bj * HALF + n * 16) = y;
                        ss += (y[0] * y[0] + y[1] * y[1]) + (y[2] * y[2] + y[3] * y[3]);
                    }
                ss += __shfl_xor(ss, 16); ss += __shfl_xor(ss, 32);
                if (fq == 0) SSF[(size_t)row * 16 + u.pn * 4 + wc] = ss;
                asm volatile("" ::: "memory");
            }
    }
};

struct EpiOutFused {
    static constexpr bool PERM = false, AFTER_DRAIN = true, MID = true, XPF = true;
    const float* x; float* out; const float* SSC; const float* SSA; float* SSF; const float* gF; unsigned* pcnt; unsigned* tmo;
    __device__ __forceinline__ void begin(const Unit& u, PG8_LAS unsigned char* lds) const {
        if (threadIdx.x < 256) { const int row = u.pm * BM + threadIdx.x;
            const float* pc = SSC + (size_t)u.pm * 64 * 256 + threadIdx.x;
            const f32x4 av0 = *(const f32x4*)(SSA + 8 * (size_t)row), av1 = *(const f32x4*)(SSA + 8 * (size_t)row + 4);
            float pv[64];
#pragma unroll
            for (int k = 0; k < 64; ++k) pv[k] = pc[k * 256];
            float c4[4] = {0.f, 0.f, 0.f, 0.f};
#pragma unroll
            for (int k = 0; k < 64; ++k) c4[k & 3] += pv[k];
            const float c = (c4[0] + c4[1]) + (c4[2] + c4[3]);
            const f32x4 av = av0 + av1; const float a = (av[0] + av[1]) + (av[2] + av[3]);
            ((PG8_LAS float*)(lds + STAGE_BYTES))[threadIdx.x] = __builtin_amdgcn_rsqf(c * (1.0f / 1024.0f) + RMS_EPS) * __builtin_amdgcn_sqrtf(a * (1.0f / 1024.0f) + RMS_EPS); }
    }
    __device__ __forceinline__ void mid(f32x4 (&acc)[2][2][4][2], const Unit& u, int wr, int fr, PG8_LAS unsigned char* lds) const {
        const PG8_LAS float* tab = (const PG8_LAS float*)(lds + STAGE_BYTES) + wr * 64 + fr;
#pragma unroll
        for (int ai = 0; ai < 2; ++ai)
#pragma unroll
            for (int m = 0; m < 4; ++m) {
                const float s = tab[ai * HALF + m * 16];
#pragma unroll
                for (int bj = 0; bj < 2; ++bj)
#pragma unroll
                    for (int n = 0; n < 2; ++n) acc[ai][bj][m][n] *= s;
            }
    }
    __device__ __forceinline__ void operator()(f32x4 (&acc)[2][2][4][2], const Unit& u, int wr, int wc, int fr, int fq, PG8_LAS unsigned char* lds) const {}
    __device__ __forceinline__ void fused(f32x4 (&acc)[2][2][4][2], const Unit& u, int wr, int wc, int fr, int fq, PG8_LAS unsigned char* lds, int wid, int lane) const {
        const int col0 = u.pn * BM + wc * 32 + 4 * fq;
#pragma unroll
        for (int ai = 0; ai < 2; ++ai) {
            f32x4 xv[4][2][2]; float ra[4];
#pragma unroll
            for (int m = 0; m < 4; ++m) {
                const int row = u.pm * BM + ai * HALF + wr * 64 + m * 16 + fr;
                const size_t off = (size_t)row * 1024 + col0;
                if (ai == 0 && !(wr == 1 && m == 3)) {
                    const int slot_buf = wr ? (m == 0 ? 6 : m == 1 ? 7 : 2) : (m == 0 ? 4 : m == 1 ? 5 : m == 2 ? 0 : 1);
                    const PG8_LAS unsigned char* xb = lds + slot_buf * HTB + (fr >> 1) * 1024 + (fr & 1) * 8192;
#pragma unroll
                    for (int bj = 0; bj < 2; ++bj)
#pragma unroll
                        for (int n = 0; n < 2; ++n) xv[m][bj][n] = *(const PG8_LAS f32x4*)(xb + 16 * ((wc * 8 + fq + bj * 32 + n * 4) ^ fr));
                } else {
#pragma unroll
                for (int bj = 0; bj < 2; ++bj)
#pragma unroll
                    for (int n = 0; n < 2; ++n) xv[m][bj][n] = __builtin_nontemporal_load((const f32x4*)(x + off + bj * HALF + n * 16));
                }
                { const f32x4 av = *(const f32x4*)(SSA + 8 * (size_t)row) + *(const f32x4*)(SSA + 8 * (size_t)row + 4); ra[m] = (av[0] + av[1]) + (av[2] + av[3]); }
            }
#pragma unroll
            for (int m = 0; m < 4; ++m) {
                const int row = u.pm * BM + ai * HALF + wr * 64 + m * 16 + fr;
                const float r = __builtin_amdgcn_rsqf(ra[m] * (1.0f / 1024.0f) + RMS_EPS);
                float ss = 0.f;
#pragma unroll
                for (int bj = 0; bj < 2; ++bj)
#pragma unroll
                    for (int n = 0; n < 2; ++n) {
                        const f32x4 y = xv[m][bj][n] + acc[ai][bj][m][n] * r;
                        acc[ai][bj][m][n] = y;
                        ss += (y[0] * y[0] + y[1] * y[1]) + (y[2] * y[2] + y[3] * y[3]);
                    }
                ss += __shfl_xor(ss, 16); ss += __shfl_xor(ss, 32);
                if (fq == 0) __hip_atomic_store(SSF + (size_t)row * 16 + u.pn * 4 + wc, ss, __ATOMIC_RELAXED, __HIP_MEMORY_SCOPE_AGENT);
            }
            asm volatile("" ::: "memory");
        }
        asm volatile("s_waitcnt vmcnt(0)" ::: "memory");
        __syncthreads();
        if (threadIdx.x == 0) {
            unsigned* pc = pcnt + 64 * u.pm;
            __hip_atomic_fetch_add(pc, 1u, __ATOMIC_RELAXED, __HIP_MEMORY_SCOPE_AGENT);
            unsigned sp = 0;
            while (__hip_atomic_load(pc, __ATOMIC_RELAXED, __HIP_MEMORY_SCOPE_AGENT) < 4u) {
                __builtin_amdgcn_s_sleep(1);
                if ((++sp & 255u) == 0u) { if (xb_ld(tmo)) break; if (sp > XB_SPIN_CAP) { atomicAdd(tmo, 1u); break; } }
            }
            __builtin_amdgcn_fence(__ATOMIC_ACQUIRE, "agent");
            asm volatile("s_waitcnt vmcnt(0)" ::: "memory");
        }
        __syncthreads();
        PG8_LAS float* tab = (PG8_LAS float*)(lds + STAGE_BYTES);
        if (threadIdx.x < 256) { const f32x4* p = (const f32x4*)(SSF + (size_t)(u.pm * BM + threadIdx.x) * 16);
            const f32x4 a = p[0], b = p[1], c = p[2], d = p[3];
            const float s = ((a[0] + a[1]) + (a[2] + a[3])) + ((b[0] + b[1]) + (b[2] + b[3])) + ((c[0] + c[1]) + (c[2] + c[3])) + ((d[0] + d[1]) + (d[2] + d[3]));
            tab[threadIdx.x] = __builtin_amdgcn_rsqf(s * (1.0f / 1024.0f) + RMS_EPS); }
        __syncthreads();
        f32x4 g[2][2];
#pragma unroll
        for (int bj = 0; bj < 2; ++bj)
#pragma unroll
            for (int n = 0; n < 2; ++n) g[bj][n] = *(const f32x4*)(gF + col0 + bj * HALF + n * 16);
#pragma unroll
        for (int ai = 0; ai < 2; ++ai)
#pragma unroll
            for (int m = 0; m < 4; ++m) {
                const int rl = ai * HALF + wr * 64 + m * 16 + fr;
                const float r = tab[rl];
                const size_t off = (size_t)(u.pm * BM + rl) * 1024 + col0;
#pragma unroll
                for (int bj = 0; bj < 2; ++bj)
#pragma unroll
                    for (int n = 0; n < 2; ++n) *(f32x4*)(out + off + bj * HALF + n * 16) = acc[ai][bj][m][n] * r * g[bj][n];
            }
    }
};

template <class Epi, class Sched, bool ALIGN_EPI = false, bool SP2 = false>
__device__ __forceinline__ void gemm_phase(PG8_LAS unsigned char* lds, const Gemm g, const Sched& S, const Epi& E) {
    const int tid = threadIdx.x, wid = __builtin_amdgcn_readfirstlane(tid >> 6), lane = tid & 63, wr = wid >> 2, wc = wid & 3, fr = lane & 15, fq = lane >> 4;
    const int K = g.K, nt = K / BK;
    unsigned voffA[2], voffB[2];
#pragma unroll
    for (int i = 0; i < 2; ++i) { int R, C; stage_rc(tid * 16 + i * 8192, R, C); const int Rb = Epi::PERM ? ((R & ~31) + perm32(R & 31)) : R;
        voffA[i] = (unsigned)(R * K + C) * 2u; voffB[i] = (unsigned)(Rb * K + C) * 2u; }
    unsigned voffX[2] = {0u, 0u};
    if constexpr (Epi::XPF) {
#pragma unroll
        for (int i = 0; i < 2; ++i) { const int rr = 2 * wid + i; voffX[i] = (unsigned)(rr * 1024 + 4 * (lane ^ rr)) * 4u; } }
    const size_t kstep = (size_t)(BK * 2);
    const size_t hstep = (size_t)HALF * K * 2;
    const size_t tstep = 2 * hstep;
    const unsigned ldsw = (unsigned)wid * 1024u;
    const int aoff = lds_byte(wr * 64 + fr, fq * 8), boff = lds_byte(wc * 32 + fr, fq * 8);
#define PG8_SA(b, h) (((b) * 2 + (h)) * HTB)
#define PG8_SB(b, h) ((4 + (b) * 2 + (h)) * HTB)
#define PG8_STAGE(bufoff, gbase, voff) do { _Pragma("unroll") for (int _i = 0; _i < 2; ++_i) \
        __builtin_amdgcn_global_load_lds((const unsigned*)((const char*)(gbase) + (voff)[_i]), (PG8_LAS unsigned*)(lds + (bufoff) + ldsw + _i * 8192), 16, 0, 0); } while (0)
#define PG8_LDA(dst, b, h) do { _Pragma("unroll") for (int m = 0; m < 4; ++m) _Pragma("unroll") for (int k = 0; k < 2; ++k) dst[m][k] = *(const PG8_LAS bf16x8*)(lds + PG8_SA(b, h) + aoff + m * 2048 + k * 1024); } while (0)
#define PG8_LDB(dst, b, h) do { _Pragma("unroll") for (int n = 0; n < 2; ++n) _Pragma("unroll") for (int k = 0; k < 2; ++k) dst[n][k] = *(const PG8_LAS bf16x8*)(lds + PG8_SB(b, h) + boff + n * 2048 + k * 1024); } while (0)
#define PG8_MMA(ai, bj, At, Bt) do { __builtin_amdgcn_s_setprio(1); _Pragma("unroll") for (int m = 0; m < 4; ++m) _Pragma("unroll") for (int n = 0; n < 2; ++n) _Pragma("unroll") for (int k = 0; k < 2; ++k) \
        acc[ai][bj][m][n] = __builtin_amdgcn_mfma_f32_16x16x32_bf16(Bt[n][k], At[m][k], acc[ai][bj][m][n], 0, 0, 0); __builtin_amdgcn_s_setprio(0); } while (0)
#define PG8_WAIT_V(n) asm volatile("s_waitcnt vmcnt(" #n ")" ::: "memory")
#define PG8_WAIT_L(n) asm volatile("s_waitcnt lgkmcnt(" #n ")" ::: "memory")
#define PG8_BAR __builtin_amdgcn_s_barrier()
#define PG8_SCHED __builtin_amdgcn_sched_barrier(0)
    Unit cur, nxt; int ui = 0;
    if (!S.next(0, cur)) return;
    f32x4 acc[2][2][4][2];
#pragma unroll
    for (int a = 0; a < 2; ++a)
#pragma unroll
        for (int b = 0; b < 2; ++b)
#pragma unroll
            for (int m = 0; m < 4; ++m)
#pragma unroll
                for (int n = 0; n < 2; ++n) acc[a][b][m][n] = (f32x4){0.f, 0.f, 0.f, 0.f};
    bf16x8 At[4][2], B0[2][2], B1[2][2];
    const char* cA = (const char*)g.A + (size_t)cur.pm * tstep; const char* cB = (const char*)g.Bt + (size_t)cur.pn * tstep;
    S.a_ready(cur);
    if constexpr (SP2) {
        PG8_STAGE(PG8_SB(0, 0), cB, voffB); PG8_STAGE(PG8_SB(0, 1), cB + hstep, voffB); PG8_STAGE(PG8_SA(0, 0), cA, voffA); PG8_STAGE(PG8_SA(0, 1), cA + hstep, voffA);
        E.begin(cur, lds);
        if (wr == 1) PG8_BAR;
        PG8_WAIT_V(2); PG8_BAR;
        PG8_STAGE(PG8_SB(1, 0), cB + kstep, voffB); PG8_STAGE(PG8_SA(1, 0), cA + kstep, voffA); PG8_STAGE(PG8_SB(1, 1), cB + hstep + kstep, voffB);
        PG8_WAIT_V(6); PG8_BAR;
    } else {
        PG8_STAGE(PG8_SB(0, 0), cB, voffB); PG8_STAGE(PG8_SA(0, 0), cA, voffA); PG8_STAGE(PG8_SB(0, 1), cB + hstep, voffB); PG8_STAGE(PG8_SA(0, 1), cA + hstep, voffA);
        E.begin(cur, lds);
        if (wr == 1) PG8_BAR;
        PG8_WAIT_V(4); PG8_BAR;
        PG8_STAGE(PG8_SB(1, 0), cB + kstep, voffB); PG8_STAGE(PG8_SA(1, 0), cA + kstep, voffA); PG8_STAGE(PG8_SB(1, 1), cB + hstep + kstep, voffB);
        PG8_WAIT_V(6); PG8_BAR;
    }
    for (;;) {
        const bool has_next = S.next(ui + 1, nxt);
        const char* nA = has_next ? (const char*)g.A + (size_t)nxt.pm * tstep : cA; const char* nB = has_next ? (const char*)g.Bt + (size_t)nxt.pn * tstep : cB;
        for (int t = 0; t < nt; t += 2) {
            if constexpr (Epi::MID) { if (t == nt / 2) E.mid(acc, cur, wr, fr, lds); }
            const bool last = (t == nt - 2);
            const char* a1 = cA + (size_t)(t + 1) * kstep;
            const char* a2 = last ? nA : cA + (size_t)(t + 2) * kstep; const char* b2 = last ? nB : cB + (size_t)(t + 2) * kstep;
            const char* a3 = a2 + kstep; const char* b3 = b2 + kstep;
            if (last && has_next) S.a_ready(nxt);
            if constexpr (SP2) {
            PG8_LDB(B0, 0, 0); PG8_LDB(B1, 0, 1); PG8_SCHED; PG8_LDA(At, 0, 0); PG8_STAGE(PG8_SA(1, 1), a1 + hstep, voffA);
            PG8_WAIT_V(8); PG8_WAIT_L(0); PG8_BAR; PG8_MMA(0, 0, At, B0); PG8_MMA(0, 1, At, B1); PG8_BAR; PG8_SCHED;
            if constexpr (Epi::XPF) {
            const bool xsel = last && !has_next;
            const char* xt = (const char*)E.x + ((size_t)cur.pm * BM * 1024 + (size_t)cur.pn * BM) * 4;
            const unsigned vB[2] = {xsel ? voffX[0] : voffB[0], xsel ? voffX[1] : voffB[1]}, vA[2] = {xsel ? voffX[0] : voffA[0], xsel ? voffX[1] : voffA[1]};
#define PG8_XR(s_) (xt + (size_t)((((s_) >> 2) * 64 + ((s_) & 3) * 16)) * 4096)
            PG8_LDA(At, 0, 1); PG8_STAGE(PG8_SB(0, 0), xsel ? PG8_XR(0) : b2, vB); PG8_STAGE(PG8_SB(0, 1), xsel ? PG8_XR(1) : b2 + hstep, vB); PG8_STAGE(PG8_SA(0, 0), xsel ? PG8_XR(2) : a2, vA);
            PG8_WAIT_V(8); PG8_WAIT_L(0); PG8_BAR; PG8_MMA(1, 0, At, B0); PG8_MMA(1, 1, At, B1); PG8_BAR; PG8_SCHED;
            PG8_LDB(B0, 1, 0); PG8_LDB(B1, 1, 1); PG8_SCHED; PG8_LDA(At, 1, 0); PG8_STAGE(PG8_SA(0, 1), xsel ? PG8_XR(3) : a2 + hstep, vA);
            PG8_WAIT_V(8); PG8_WAIT_L(0); PG8_BAR; PG8_MMA(0, 0, At, B0); PG8_MMA(0, 1, At, B1); PG8_BAR; PG8_SCHED;
            PG8_LDA(At, 1, 1); PG8_STAGE(PG8_SB(1, 0), xsel ? PG8_XR(4) : b3, vB); PG8_STAGE(PG8_SB(1, 1), xsel ? PG8_XR(5) : b3 + hstep, vB); PG8_STAGE(PG8_SA(1, 0), xsel ? PG8_XR(6) : a3, vA);
            PG8_WAIT_V(8); PG8_WAIT_L(0); PG8_BAR; PG8_MMA(1, 0, At, B0); PG8_MMA(1, 1, At, B1); PG8_BAR; PG8_SCHED;
#undef PG8_XR
            } else {
            PG8_LDA(At, 0, 1); PG8_STAGE(PG8_SB(0, 0), b2, voffB); PG8_STAGE(PG8_SB(0, 1), b2 + hstep, voffB); PG8_STAGE(PG8_SA(0, 0), a2, voffA);
            PG8_WAIT_V(8); PG8_WAIT_L(0); PG8_BAR; PG8_MMA(1, 0, At, B0); PG8_MMA(1, 1, At, B1); PG8_BAR; PG8_SCHED;
            PG8_LDB(B0, 1, 0); PG8_LDB(B1, 1, 1); PG8_SCHED; PG8_LDA(At, 1, 0); PG8_STAGE(PG8_SA(0, 1), a2 + hstep, voffA);
            PG8_WAIT_V(8); PG8_WAIT_L(0); PG8_BAR; PG8_MMA(0, 0, At, B0); PG8_MMA(0, 1, At, B1); PG8_BAR; PG8_SCHED;
            PG8_LDA(At, 1, 1); PG8_STAGE(PG8_SB(1, 0), b3, voffB); PG8_STAGE(PG8_SB(1, 1), b3 + hstep, voffB); PG8_STAGE(PG8_SA(1, 0), a3, voffA);
            PG8_WAIT_V(8); PG8_WAIT_L(0); PG8_BAR; PG8_MMA(1, 0, At, B0); PG8_MMA(1, 1, At, B1); PG8_BAR; PG8_SCHED;
            }
            } else {
            PG8_LDB(B0, 0, 0); PG8_SCHED; PG8_LDA(At, 0, 0); PG8_STAGE(PG8_SA(1, 1), a1 + hstep, voffA);
            PG8_WAIT_L(8); PG8_BAR; PG8_WAIT_L(0); PG8_MMA(0, 0, At, B0); PG8_BAR; PG8_SCHED;
            PG8_LDB(B1, 0, 1); PG8_STAGE(PG8_SB(0, 0), b2, voffB);
            PG8_BAR; PG8_WAIT_L(0); PG8_MMA(0, 1, At, B1); PG8_BAR;
            PG8_LDA(At, 0, 1); PG8_STAGE(PG8_SA(0, 0), a2, voffA);
            PG8_BAR; PG8_WAIT_L(0); PG8_MMA(1, 0, At, B0); PG8_BAR; PG8_SCHED;
            PG8_STAGE(PG8_SB(0, 1), b2 + hstep, voffB);
            PG8_WAIT_V(6); PG8_BAR; PG8_MMA(1, 1, At, B1); PG8_BAR;
            PG8_LDB(B0, 1, 0); PG8_SCHED; PG8_LDA(At, 1, 0); PG8_STAGE(PG8_SA(0, 1), a2 + hstep, voffA);
            PG8_WAIT_L(8); PG8_BAR; PG8_WAIT_L(0); PG8_MMA(0, 0, At, B0); PG8_BAR; PG8_SCHED;
            PG8_LDB(B1, 1, 1); PG8_STAGE(PG8_SB(1, 0), b3, voffB);
            PG8_BAR; PG8_WAIT_L(0); PG8_MMA(0, 1, At, B1); PG8_BAR;
            PG8_LDA(At, 1, 1); PG8_STAGE(PG8_SA(1, 0), a3, voffA);
            PG8_BAR; PG8_WAIT_L(0); PG8_MMA(1, 0, At, B0); PG8_BAR; PG8_SCHED;
            PG8_STAGE(PG8_SB(1, 1), b3 + hstep, voffB);
            PG8_WAIT_V(6); PG8_BAR; PG8_MMA(1, 1, At, B1); PG8_BAR;
            }
        }
        if constexpr (ALIGN_EPI) { if (wr == 0) PG8_BAR; }
        if constexpr (!Epi::AFTER_DRAIN) { E(acc, cur, wr, wc, fr, fq, lds); S.done(cur); }
        if (!has_next) break;
#pragma unroll
        for (int a = 0; a < 2; ++a)
#pragma unroll
            for (int b = 0; b < 2; ++b)
#pragma unroll
                for (int m = 0; m < 4; ++m)
#pragma unroll
                    for (int n = 0; n < 2; ++n) acc[a][b][m][n] = (f32x4){0.f, 0.f, 0.f, 0.f};
        cur = nxt; cA = nA; cB = nB; ++ui;
        E.begin(cur, lds);
        if constexpr (ALIGN_EPI) { if (wr == 1) PG8_BAR; }
    }
    PG8_WAIT_V(0);
    if constexpr (!ALIGN_EPI) { if (wr == 0) PG8_BAR; }
    PG8_BAR;
    if constexpr (Epi::AFTER_DRAIN) { E.fused(acc, cur, wr, wc, fr, fq, lds, wid, lane); S.done(cur); }
#undef PG8_SA
#undef PG8_SB
#undef PG8_STAGE
#undef PG8_LDA
#undef PG8_LDB
#undef PG8_MMA
#undef PG8_WAIT_V
#undef PG8_WAIT_L
#undef PG8_BAR
#undef PG8_SCHED
}
}
constexpr int M = 16384, DM = 1024, NPROJ = 6400, DMIX = 2048, SEQ = 2048;
constexpr int QP = 2304;
constexpr size_t MiB = 1u << 20;
constexpr size_t WS_SSA = 9 * MiB, WS_SSF = 512 * 1024;
constexpr size_t WS_WOUT = 2 * MiB;
constexpr size_t WS_HALO = 6 * MiB;
constexpr size_t WS_DEF = 7 * MiB;
constexpr size_t WS_WIN = 10 * MiB;
constexpr size_t WS_XN = 24 * MiB;
constexpr size_t WS_MIX = 56 * MiB;
constexpr size_t WS_QKVG = 120 * MiB;
constexpr size_t WS_SSC = 192 * MiB;
constexpr size_t WS_END = 196 * MiB;
constexpr int NWAVES = 8;
constexpr int LDS_BYTES = 147456;
typedef unsigned short bf16;
typedef unsigned v4u __attribute__((ext_vector_type(4)));
typedef unsigned v2u __attribute__((ext_vector_type(2)));
typedef float f32x4 __attribute__((ext_vector_type(4)));
typedef float f32x16 __attribute__((ext_vector_type(16)));
typedef short bf16x8 __attribute__((ext_vector_type(8)));
typedef short s16x4 __attribute__((ext_vector_type(4)));
#define LDS_WAIT() asm volatile("s_waitcnt lgkmcnt(0)" ::: "memory")
__device__ __forceinline__ unsigned pk2(float lo, float hi) { return pg8::cvt_pk_bf16(lo, hi); }
__device__ __forceinline__ float bflo(unsigned w) { return __uint_as_float(w << 16); }
__device__ __forceinline__ float bfhi(unsigned w) { return __uint_as_float(w & 0xffff0000u); }
__device__ __forceinline__ float wave_sum(float v) {
#pragma unroll
    for (int o = 1; o < 64; o <<= 1) v += __shfl_xor(v, o);
    return v;
}
__device__ __forceinline__ float silu(float g) { return g * __builtin_amdgcn_rcpf(1.0f + __builtin_amdgcn_exp2f(-1.4426950408889634f * g)); }

__device__ __forceinline__ int win_dst_row(int n) {
    if (n < 4096) { const int s = n >> 10, jc = n & 1023, j = jc >> 6, ch = jc & 63, wc = ch >> 4, fq = (ch >> 2) & 3, i = ch & 3, bj = s >> 1, nn = s & 1;
        return 2304 + 256 * j + 128 * bj + 32 * wc + 16 * nn + 4 * fq + i; }
    const int a = n - 4096, pn = a >> 8, lg = a & 255, bj = lg >> 7, wc = (lg >> 5) & 3, fq = (lg >> 3) & 3, nn = (lg >> 2) & 1, i = lg & 3;
    return 256 * pn + 128 * bj + 32 * wc + 16 * nn + 4 * fq + i;
}
template <bool PERMUTE>
__device__ __forceinline__ void p0_transpose_item(const float* W, int K, int N, bf16* WT, LAS float* scr, int item, int lane) {
    const int nblk = N / 32, kb = item / nblk, nb = item % nblk, k0 = 64 * kb, n0 = 32 * nb;
    float wv[32];
#pragma unroll
    for (int i = 0; i < 32; ++i) wv[i] = __builtin_nontemporal_load(W + (size_t)(k0 + 2 * i + (lane >> 5)) * N + n0 + (lane & 31));
#pragma unroll
    for (int i = 0; i < 32; ++i) scr[(2 * i + (lane >> 5)) * 33 + (lane & 31)] = wv[i];
    LDS_WAIT(); asm volatile("" ::: "memory");
    const int c = lane & 7;
#pragma unroll
    for (int j = 0; j < 4; ++j) { const int n = (lane >> 3) + 8 * j; const LAS float* s = scr + (8 * c) * 33 + n;
        v4u o; o.x = pk2(s[0 * 33], s[1 * 33]); o.y = pk2(s[2 * 33], s[3 * 33]); o.z = pk2(s[4 * 33], s[5 * 33]); o.w = pk2(s[6 * 33], s[7 * 33]);
        const int dr = PERMUTE ? win_dst_row(n0 + n) : (n0 + n);
        if (PERMUTE && n0 < 4096) __builtin_nontemporal_store(o, (v4u*)(WT + (size_t)dr * K + k0 + 8 * c));
        else if (!PERMUTE) st_wt16(WT + (size_t)dr * K + k0 + 8 * c, o);
        else *(v4u*)(WT + (size_t)dr * K + k0 + 8 * c) = o; }
    LDS_WAIT(); asm volatile("" ::: "memory");
}
__device__ __forceinline__ void rms_row_to_bf16(const float* xrow, const float* g, bf16* orow, int lane) {
    const f32x4* xr = (const f32x4*)xrow + lane; const f32x4* gr = (const f32x4*)g + lane;
    f32x4 v[4]; float s = 0.f;
#pragma unroll
    for (int j = 0; j < 4; ++j) { v[j] = xr[64 * j]; s += (v[j].x * v[j].x + v[j].y * v[j].y) + (v[j].z * v[j].z + v[j].w * v[j].w); }
    const float rstd = __builtin_amdgcn_rsqf(wave_sum(s) * (1.f / DM) + pg8::RMS_EPS);
    unsigned long long* o8 = (unsigned long long*)orow + lane;
#pragma unroll
    for (int j = 0; j < 4; ++j) { const f32x4 gg = gr[64 * j]; const f32x4 y = v[j] * rstd * gg;
        o8[64 * j] = (unsigned long long)pk2(y.x, y.y) | ((unsigned long long)pk2(y.z, y.w) << 32); }
}

__device__ __forceinline__ void rms_rows4_to_bf16(const float* xrow, const float* g, bf16* orow, int lane) {
    f32x4 v[4][4]; float s[4];
#pragma unroll
    for (int r = 0; r < 4; ++r) { const f32x4* xr = (const f32x4*)(xrow + (size_t)r * DM) + lane;
#pragma unroll
        for (int j = 0; j < 4; ++j) v[r][j] = __builtin_nontemporal_load(xr + 64 * j); }
#pragma unroll
    for (int r = 0; r < 4; ++r) { float t = 0.f;
#pragma unroll
        for (int j = 0; j < 4; ++j) t += (v[r][j].x * v[r][j].x + v[r][j].y * v[r][j].y) + (v[r][j].z * v[r][j].z + v[r][j].w * v[r][j].w);
        s[r] = t; }
#pragma unroll
    for (int o = 1; o < 64; o <<= 1) {
#pragma unroll
        for (int r = 0; r < 4; ++r) s[r] += __shfl_xor(s[r], o); }
    const f32x4* gr = (const f32x4*)g + lane;
#pragma unroll
    for (int r = 0; r < 4; ++r) { const float rstd = __builtin_amdgcn_rsqf(s[r] * (1.f / DM) + pg8::RMS_EPS);
        unsigned long long* o8 = (unsigned long long*)(orow + (size_t)r * DM) + lane;
#pragma unroll
        for (int j = 0; j < 4; ++j) { const f32x4 y = v[r][j] * rstd * gr[64 * j];
            o8[64 * j] = (unsigned long long)pk2(y.x, y.y) | ((unsigned long long)pk2(y.z, y.w) << 32); } }
}

constexpr int KP = 72, VP = 264;
constexpr int LDS_KS = 0, LDS_VT = 256 * KP * 2, LDS_SS = LDS_VT + 64 * VP * 2, LDS_WT = LDS_SS + 4096 + 2048;
__device__ __forceinline__ void attn_unit(LAS unsigned char* lds, int unit, int mode, const bf16* QKVG, const float* sinks, const float* gain_a, bf16* MIX, float* SSA) {
    const int tid = threadIdx.x, lane = tid & 63, w = __builtin_amdgcn_readfirstlane(tid >> 6);
    const int kvh = unit & 1, blk = unit >> 1, nblk = blk & 15, T0 = blk * 128;
    const int hl = (mode == 0) ? w : (mode <= 2) ? (4 * (mode - 1) + (w & 3)) : (2 * (mode - 3) + (w & 1));
    const int i0 = (mode == 0) ? 0 : (mode <= 2) ? 2 * (w >> 2) : (w >> 1), i1 = (mode == 0) ? 4 : (mode <= 2) ? i0 + 2 : i0 + 1;
    LAS bf16* Ks = (LAS bf16*)(lds + LDS_KS); LAS bf16* Vt = (LAS bf16*)(lds + LDS_VT); LAS float* SS = (LAS float*)(lds + LDS_SS);
    const int h = kvh * 8 + hl, q = lane & 31, hh = lane >> 5;
    SS[tid] = 0.f; SS[tid + 512] = 0.f;
    const int r8 = lane >> 3, c8 = lane & 7;
    const bf16* qrow0 = QKVG + (size_t)(T0 + r8) * QP + h * 64 + 8 * c8;
    const bf16* grow0 = qrow0 + 1280;
    LAS bf16* WT = (LAS bf16*)(lds + LDS_WT) + w * (32 * KP);
    LAS bf16* wt_row = WT + r8 * KP + 8 * c8;
    LAS bf16* wt_frq = WT + q * KP + 8 * hh;
    LAS bf16* wt_frd = WT + q * KP + 4 * hh;
    bf16x8 qr[4]; v2u gt[8]; v4u qrow[4], grow[4];
#pragma unroll
    for (int k = 0; k < 4; ++k) qrow[k] = __builtin_nontemporal_load((const v4u*)(qrow0 + (size_t)(32 * i0 + 8 * k) * QP));
    {
        const int rp = tid >> 2, qd = tid & 3, row = 2 * rp;
        const bool valid = (nblk > 0) || (row >= 128);
        const int tok = valid ? (T0 - 128 + row) : T0;
        const bf16* src = QKVG + (size_t)tok * QP + 1024 + kvh * 64 + qd * 16;
        v4u k0[2], k1[2], v0[2], v1[2];
#pragma unroll
        for (int c = 0; c < 2; ++c) { k0[c] = *(const v4u*)(src + 8 * c); k1[c] = *(const v4u*)(src + QP + 8 * c); v0[c] = *(const v4u*)(src + 128 + 8 * c); v1[c] = *(const v4u*)(src + QP + 128 + 8 * c);
            if (!valid) { k0[c] = k1[c] = v0[c] = v1[c] = (v4u){0u, 0u, 0u, 0u}; } }
#pragma unroll
        for (int c = 0; c < 2; ++c) { *(LAS v4u*)(Ks + row * KP + qd * 16 + 8 * c) = k0[c]; *(LAS v4u*)(Ks + (row + 1) * KP + qd * 16 + 8 * c) = k1[c]; }
        const int kq = row & 15, pos = (row & ~15) + (kq & 3) + 4 * ((kq >> 3) & 1) + 8 * ((kq >> 2) & 1);
#pragma unroll
        for (int c = 0; c < 2; ++c)
#pragma unroll
            for (int e = 0; e < 4; ++e) { const unsigned a = v0[c][e], b = v1[c][e];
                *(LAS unsigned*)(Vt + (qd * 16 + 8 * c + 2 * e) * VP + pos) = (a & 0xffffu) | (b << 16);
                *(LAS unsigned*)(Vt + (qd * 16 + 8 * c + 2 * e + 1) * VP + pos) = (a >> 16) | (b & 0xffff0000u); }
    }
    __syncthreads();
    constexpr float LOG2E = 1.4426950408889634f;
    const float slope2 = exp2f(-0.5f * (float)(h + 1)) * LOG2E, sink2 = sinks[h] * LOG2E;
    LAS float* GN = SS + 8 * 128 + w * 64;
    GN[lane] = gain_a[h * 64 + lane];
#pragma unroll
    for (int k = 0; k < 4; ++k) *(LAS v4u*)(wt_row + 8 * k * KP) = qrow[k];
#pragma unroll
    for (int s = 0; s < 4; ++s) qr[s] = *(const LAS bf16x8*)(wt_frq + 16 * s);
    for (int i = i0; i < i1; ++i) {
        const int inx = (i < 3) ? (i + 1) : 3;
#pragma unroll
        for (int k = 0; k < 4; ++k) qrow[k] = __builtin_nontemporal_load((const v4u*)(qrow0 + (size_t)(32 * inx + 8 * k) * QP));
#pragma unroll
        for (int k = 0; k < 4; ++k) grow[k] = __builtin_nontemporal_load((const v4u*)(grow0 + (size_t)(32 * i + 8 * k) * QP));
        int qq = q - 4 * hh; asm volatile("" : "+v"(qq));
        float base = slope2 * (float)(4 * hh); asm volatile("" : "+v"(base));
        f32x16 st[5];
#pragma unroll
        for (int j = 0; j < 5; ++j) {
            const bool tile_ok = !(nblk == 0 && (i + j) < 4);
            const float sl = tile_ok ? slope2 : 0.f, bs = tile_ok ? base : -INFINITY;
#pragma unroll
            for (int r = 0; r < 16; ++r) st[j][r] = fmaf(sl, (float)((r & 3) + 8 * (r >> 2) + 32 * j), bs);
        }
        {
            const LAS bf16* kp = Ks + (32 * i + q) * KP + hh * 8;
            bf16x8 kf[2][5];
#pragma unroll
            for (int j = 0; j < 5; ++j) kf[0][j] = *(const LAS bf16x8*)(kp + j * 32 * KP);
#pragma unroll
            for (int s = 0; s < 4; ++s) {
                if (s < 3) {
#pragma unroll
                    for (int j = 0; j < 5; ++j) kf[(s + 1) & 1][j] = *(const LAS bf16x8*)(kp + j * 32 * KP + 16 * (s + 1));
                }
#pragma unroll
                for (int j = 0; j < 5; ++j) st[j] = __builtin_amdgcn_mfma_f32_32x32x16_bf16(kf[s & 1][j], qr[s], st[j], 0, 0, 0);
            }
        }
        const float sinkq = fmaf(slope2, (float)(128 + 4 * hh) + (float)qq, sink2);
        float mx = sinkq;
#pragma unroll
        for (int r = 0; r < 16; ++r) {
            const int cr = (r & 3) + 8 * (r >> 2);
            const bool up = cr > qq;
            st[0][r] = up ? st[0][r] : -INFINITY;
            st[4][r] = up ? -INFINITY : st[4][r];
        }
#pragma unroll
        for (int j = 0; j < 5; ++j)
#pragma unroll
            for (int r = 0; r < 16; ++r) mx = fmaxf(mx, st[j][r]);
        mx = fmaxf(mx, __shfl_xor(mx, 32));
        float sum = 0.f;
#pragma unroll
        for (int j = 0; j < 5; ++j)
#pragma unroll
            for (int r = 0; r < 16; ++r) { const float p = __builtin_amdgcn_exp2f(st[j][r] - mx); st[j][r] = p; sum += p; }
        sum += __shfl_xor(sum, 32);
        sum += __builtin_amdgcn_exp2f(sinkq - mx);
        const float inv = __builtin_amdgcn_rcpf(sum);
        f32x16 ot[2]; ot[0] = f32x16{}; ot[1] = f32x16{};
#pragma unroll
        for (int j = 0; j < 5; ++j)
#pragma unroll
            for (int s2 = 0; s2 < 2; ++s2) {
                v4u pw; pw.x = pk2(st[j][8 * s2 + 0], st[j][8 * s2 + 1]); pw.y = pk2(st[j][8 * s2 + 2], st[j][8 * s2 + 3]);
                pw.z = pk2(st[j][8 * s2 + 4], st[j][8 * s2 + 5]); pw.w = pk2(st[j][8 * s2 + 6], st[j][8 * s2 + 7]);
                const bf16x8 pf = __builtin_bit_cast(bf16x8, pw);
#pragma unroll
                for (int db = 0; db < 2; ++db) {
                    const bf16x8 vf = *(const LAS bf16x8*)(Vt + (db * 32 + q) * VP + 32 * (i + j) + 16 * s2 + 8 * hh);
                    ot[db] = __builtin_amdgcn_mfma_f32_32x32x16_bf16(vf, pf, ot[db], 0, 0, 0);
                }
            }
        float ss = 0.f;
#pragma unroll
        for (int k = 0; k < 4; ++k) *(LAS v4u*)(wt_row + 8 * k * KP) = grow[k];
#pragma unroll
        for (int e = 0; e < 8; ++e) gt[e] = *(const LAS v2u*)(wt_frd + 32 * (e >> 2) + 8 * (e & 3));
#pragma unroll
        for (int e = 0; e < 8; ++e) {
            const int db = e >> 2, g4 = e & 3;
            const float o0 = ot[db][4 * g4 + 0] * inv, o1 = ot[db][4 * g4 + 1] * inv, o2 = ot[db][4 * g4 + 2] * inv, o3 = ot[db][4 * g4 + 3] * inv;
            ss += (o0 * o0 + o1 * o1) + (o2 * o2 + o3 * o3);
            const f32x4 gn = *(const LAS f32x4*)(GN + 4 * hh + 32 * db + 8 * g4);
            v2u z; z.x = pk2(o0 * gn[0] * silu(bflo(gt[e].x)), o1 * gn[1] * silu(bfhi(gt[e].x)));
            z.y = pk2(o2 * gn[2] * silu(bflo(gt[e].y)), o3 * gn[3] * silu(bfhi(gt[e].y)));
            *(LAS v2u*)(wt_frd + 32 * db + 8 * g4) = z;
        }
        {
            bf16* orow0 = MIX + (size_t)(T0 + 32 * i + r8) * DMIX + 1024 + h * 64 + 8 * c8;
#pragma unroll
            for (int k = 0; k < 4; ++k) { const v4u v = *(const LAS v4u*)(wt_row + 8 * k * KP); *(v4u*)(orow0 + (size_t)(8 * k) * DMIX) = v; }
        }
#pragma unroll
        for (int k = 0; k < 4; ++k) *(LAS v4u*)(wt_row + 8 * k * KP) = qrow[k];
        ss += __shfl_xor(ss, 32);
        if (hh == 0) SS[w * 128 + 32 * i + q] = ss;
#pragma unroll
        for (int s = 0; s < 4; ++s) qr[s] = *(const LAS bf16x8*)(wt_frq + 16 * s);
    }
    __syncthreads();
    if (tid < 128) { float s = 0.f;
#pragma unroll
        for (int ww = 0; ww < 8; ++ww) s += SS[ww * 128 + tid];
        float* sa = SSA + (size_t)(T0 + tid) * 8 + kvh * 4;
        if (mode == 0) *(f32x4*)sa = (f32x4){s, 0.f, 0.f, 0.f};
        else if (mode <= 2) { sa[2 * (mode - 1)] = s; sa[2 * (mode - 1) + 1] = 0.f; }
        else sa[mode - 3] = s; }
    __syncthreads();
}

__device__ __forceinline__ void conv_fixup(int idx, int lane, const float* DEF, const float* HALO, const float* conv_w, const float* gain_c, bf16* MIX, float* SSC) {
    const int pm = idx >> 1, rho = idx & 1;
    if ((pm & 7) == 0) return;
    const int c = lane * 16, t = pm * 256 + rho;
    const float* d = DEF + ((size_t)(pm * 2 + rho) * 3) * 1024 + c;
    const float* p1 = rho ? (DEF + ((size_t)(pm * 2) * 3 + 1) * 1024 + c) : (HALO + ((size_t)(pm - 1) * 2 + 1) * 1024 + c);
    const float* p2 = rho ? (HALO + ((size_t)(pm - 1) * 2 + 1) * 1024 + c) : (HALO + ((size_t)(pm - 1) * 2) * 1024 + c);
    float ss = 0.f; unsigned zw[8];
#pragma unroll
    for (int e4 = 0; e4 < 4; ++e4) {
        const f32x4 cb = *(const f32x4*)(d + 4 * e4), u0 = *(const f32x4*)(d + 1024 + 4 * e4), g = *(const f32x4*)(d + 2048 + 4 * e4), u1 = *(const f32x4*)(p1 + 4 * e4), u2 = *(const f32x4*)(p2 + 4 * e4);
        const f32x4 w0 = *(const f32x4*)(conv_w + c + 4 * e4), w1 = *(const f32x4*)(conv_w + 1024 + c + 4 * e4), w2 = *(const f32x4*)(conv_w + 2048 + c + 4 * e4), gn = *(const f32x4*)(gain_c + c + 4 * e4);
        const f32x4 raw = cb * (w0 * u2 + w1 * u1 + w2 * u0);
        ss += (raw[0] * raw[0] + raw[1] * raw[1]) + (raw[2] * raw[2] + raw[3] * raw[3]);
        zw[2 * e4] = pk2(raw[0] * gn[0] * silu(g[0]), raw[1] * gn[1] * silu(g[1])); zw[2 * e4 + 1] = pk2(raw[2] * gn[2] * silu(g[2]), raw[3] * gn[3] * silu(g[3]));
    }
    *(v4u*)(MIX + (size_t)t * DMIX + c) = (v4u){zw[0], zw[1], zw[2], zw[3]}; *(v4u*)(MIX + (size_t)t * DMIX + c + 8) = (v4u){zw[4], zw[5], zw[6], zw[7]};
    ss = wave_sum(ss); if (lane == 0) SSC[(size_t)pm * 64 * 256 + rho] = ss;
}

__device__ __forceinline__ void group_arrive(unsigned* cnt) {
    asm volatile("s_waitcnt vmcnt(0)" ::: "memory");
    __syncthreads();
    if (threadIdx.x == 0) __hip_atomic_fetch_add(cnt, 1u, __ATOMIC_RELAXED, __HIP_MEMORY_SCOPE_AGENT);
}
__device__ __forceinline__ void group_wait(unsigned* cnt, unsigned want, unsigned* bar) {
    if (threadIdx.x == 0) {
        unsigned sp = 0;
        while (__hip_atomic_load(cnt, __ATOMIC_RELAXED, __HIP_MEMORY_SCOPE_AGENT) < want) {
            __builtin_amdgcn_s_sleep(2);
            if ((++sp & 255u) == 0u) { if (xb_ld(&bar[XB_TMO])) break; if (sp > XB_SPIN_CAP) { atomicAdd(&bar[XB_TMO], 1u); break; } }
        }
        __builtin_amdgcn_fence(__ATOMIC_ACQUIRE, "agent");
        asm volatile("s_waitcnt vmcnt(0)" ::: "memory");
    }
    __syncthreads();
}

constexpr size_t WS_BAR = 1536 * 1024;
constexpr int LDS_TAB = 131072, LDS_MISC = LDS_TAB + 1024;
struct Args { const float *x, *norm_in, *w_in, *conv_w, *sinks, *norm_conv, *norm_attn, *w_out, *norm_final; float* out; unsigned char* ws; int use_cg; int pad; };
__global__ void __launch_bounds__(NWAVES * 64, 2) fwd_megakernel(Args a) {
    extern __shared__ __attribute__((aligned(16))) unsigned char lds_raw[];
    LAS unsigned char* lds = (LAS unsigned char*)lds_raw;
    const int tid = threadIdx.x, lane = tid & 63, wave = __builtin_amdgcn_readfirstlane(tid >> 6);
    const int G = gridDim.x, gw = blockIdx.x * NWAVES + wave, NGW = G * NWAVES;
    unsigned char* ws = a.ws;
    float* SSC = (float*)(ws + WS_SSC); float* SSA = (float*)(ws + WS_SSA); float* SSF = (float*)(ws + WS_SSF);
    bf16* WOUT = (bf16*)(ws + WS_WOUT); bf16* WIN = (bf16*)(ws + WS_WIN); bf16* XN = (bf16*)(ws + WS_XN); bf16* MIX = (bf16*)(ws + WS_MIX);
    bf16* QKVG = (bf16*)(ws + WS_QKVG); float* HALO = (float*)(ws + WS_HALO); float* DEF = (float*)(ws + WS_DEF);
    if (a.use_cg) cg::this_grid().sync();
    volatile LAS unsigned* MISC = (volatile LAS unsigned*)(lds + LDS_MISC);
    if (tid < 32) MISC[tid] = 0u;
    __syncthreads();
    const XcdBarrier bar = xcd_barrier_post((unsigned*)(ws + WS_BAR), MISC + 8, gridDim.x);
    const XcdBarrier gbar = xcd_barrier_post((unsigned*)(ws + WS_BAR + 65536) + (blockIdx.x & 7) * 4096, MISC + 10, 32u);
    unsigned* gwo = (unsigned*)(ws + WS_BAR) + 3520;

    {
        LAS float* scr = (LAS float*)(lds + wave * 16384);
        constexpr int I_IN = (DM / 64) * (NPROJ / 32);
        if (G == 256) {
            { const int kb = gw >> 7, nb = gw & 127; p0_transpose_item<true>(a.w_in, DM, NPROJ, WIN, scr, kb * (NPROJ / 32) + nb, lane); }
            if (gw < 1152) { const int kb = gw / 72, nb = 128 + gw % 72; p0_transpose_item<true>(a.w_in, DM, NPROJ, WIN, scr, kb * (NPROJ / 32) + nb, lane); }
        } else
        for (int it = gw; it < I_IN; it += NGW) p0_transpose_item<true>(a.w_in, DM, NPROJ, WIN, scr, it, lane);
        for (int m = gw * 4; m < M; m += NGW * 4) rms_rows4_to_bf16(a.x + (size_t)m * DM, a.norm_in, XN + (size_t)m * DM, lane);
    }
    xcd_barrier(bar);
    {
        pg8::Gemm g{XN, WIN, M, NPROJ, DM}; pg8::ArriveOrder S; S.init(M, NPROJ, G, (int)blockIdx.x);
        pg8::EpiInProj E{MIX, QKVG, a.conv_w, a.norm_conv, SSC, HALO, DEF};
        const bool flow = (G == 256);
        unsigned* gca = (unsigned*)(ws + WS_BAR) + 4096 + 64 * (blockIdx.x & 7);
        unsigned* gcc = (unsigned*)(ws + WS_BAR) + 8192 + 64 * (blockIdx.x & 7);
        S.cnt = flow ? gca : nullptr; S.first_pn = (blockIdx.x < 64) ? 12 : 8 + (int)(blockIdx.x >> 6);
        pg8::gemm_phase<pg8::EpiInProj, pg8::ArriveOrder, true, true>(lds, g, S, E);
        if (flow) {
            group_arrive(gcc);
            const int gb = blockIdx.x & 7, l = blockIdx.x >> 3;
            if (l >= 8) {
                group_wait(gca, 256u, (unsigned*)(ws + WS_BAR));
                attn_unit(lds, gb * 32 + l, 0, QKVG, a.sinks, a.norm_attn, MIX, SSA);
                {
                    LAS float* scr = (LAS float*)(lds + wave * 16384);
                    constexpr int I_OUT = (DMIX / 64) * (DM / 32);
                    const int it = ((blockIdx.x & 7) * 24 + (l - 8)) * NWAVES + wave;
                    if (it < I_OUT) p0_transpose_item<false>(a.w_out, DMIX, DM, WOUT, scr, it, lane);
                    asm volatile("s_waitcnt vmcnt(0)" ::: "memory");
                    __syncthreads();
                    if (tid == 0) __hip_atomic_fetch_add(gwo, 1u, __ATOMIC_RELAXED, __HIP_MEMORY_SCOPE_AGENT);
                }
            } else group_wait(gca, 256u, (unsigned*)(ws + WS_BAR));
            attn_unit(lds, gb * 32 + (l >> 2), 3 + (l & 3), QKVG, a.sinks, a.norm_attn, MIX, SSA);
            if (l >= 24) {
                group_wait(gcc, 32u, (unsigned*)(ws + WS_BAR));
                if (l != 24 && wave < 2) conv_fixup(2 * (gb * 8 + (l - 24)) + wave, lane, DEF, HALO, a.conv_w, a.norm_conv, MIX, SSC);
            }
        } else {
            xcd_barrier(bar);
            for (int unit = blockIdx.x; unit < 256; unit += G) attn_unit(lds, unit, 0, QKVG, a.sinks, a.norm_attn, MIX, SSA);
            for (int idx = gw; idx < 128; idx += NGW) conv_fixup(idx, lane, DEF, HALO, a.conv_w, a.norm_conv, MIX, SSC);
            LAS float* scr = (LAS float*)(lds + wave * 16384);
            constexpr int I_OUT = (DMIX / 64) * (DM / 32);
            for (int it = gw; it < I_OUT; it += NGW) p0_transpose_item<false>(a.w_out, DMIX, DM, WOUT, scr, it, lane);
        }
    }
    if (G == 256) { xcd_barrier(gbar); group_wait(gwo, 192u, (unsigned*)(ws + WS_BAR)); }
    else xcd_barrier(bar);
    if (G == 256) {
        pg8::Gemm g{MIX, WOUT, M, DM, DMIX}; pg8::StaticOrder S; S.init(M, DM, G, (int)blockIdx.x);
        pg8::EpiOutFused E{a.x, a.out, SSC, SSA, SSF, a.norm_final, (unsigned*)(ws + WS_BAR) + 12288, (unsigned*)(ws + WS_BAR) + XB_TMO};
        pg8::gemm_phase<pg8::EpiOutFused, pg8::StaticOrder, false, true>(lds, g, S, E);
    } else {
        {
            pg8::Gemm g{MIX, WOUT, M, DM, DMIX}; pg8::StaticOrder S; S.init(M, DM, G, (int)blockIdx.x);
            pg8::EpiOut E{a.x, a.out, SSC, SSA, SSF};
            pg8::gemm_phase<pg8::EpiOut, pg8::StaticOrder, true, true>(lds, g, S, E);
        }
        xcd_barrier(bar);
        for (int m = gw; m < M; m += NGW) {
            float s = SSF[(size_t)m * 16 + (lane & 15)];
            s += __shfl_xor(s, 1); s += __shfl_xor(s, 2); s += __shfl_xor(s, 4); s += __shfl_xor(s, 8);
            const float rstd = __builtin_amdgcn_rsqf(s * (1.f / DM) + pg8::RMS_EPS);
            f32x4* o = (f32x4*)(a.out + (size_t)m * DM) + lane; const f32x4* gf = (const f32x4*)a.norm_final + lane;
#pragma unroll
            for (int j = 0; j < 4; ++j) o[64 * j] = o[64 * j] * rstd * gf[64 * j];
        }
    }
}

extern "C" void kernel_launch(void* const* d_in, const int* in_sizes, int n_in, void* d_out, int out_size, void* d_ws, size_t ws_size, hipStream_t stream) {
    static int grid = 0;
    if (grid == 0) {
        if (n_in != 9 || in_sizes[0] != M * DM || out_size != M * DM || ws_size < WS_END) { fprintf(stderr, "kernel_launch: unexpected shapes (n_in %d in0 %d out %d ws %zu)\n", n_in, n_in > 0 ? in_sizes[0] : -1, out_size, ws_size); grid = -1; return; }
        int dev = 0, cus = 0, per_cu = 0;
        (void)hipGetDevice(&dev); (void)hipDeviceGetAttribute(&cus, hipDeviceAttributeMultiprocessorCount, dev);
        if (hipFuncSetAttribute((const void*)fwd_megakernel, hipFuncAttributeMaxDynamicSharedMemorySize, LDS_BYTES) != hipSuccess) { fprintf(stderr, "kernel_launch: hipFuncSetAttribute failed\n"); grid = -1; return; }
        if (hipOccupancyMaxActiveBlocksPerMultiprocessor(&per_cu, (const void*)fwd_megakernel, NWAVES * 64, LDS_BYTES) != hipSuccess || per_cu < 1) { fprintf(stderr, "kernel_launch: occupancy query says %d\n", per_cu); per_cu = 1; }
        (void)hipGetLastError();
        grid = cus * 1;
    }
    if (grid < 0) return;
    (void)hipMemsetAsync((unsigned char*)d_ws + WS_BAR, 0, 65536 + 8 * 16384, stream);
    Args a{};
    a.x = (const float*)d_in[0]; a.norm_in = (const float*)d_in[1]; a.w_in = (const float*)d_in[2]; a.conv_w = (const float*)d_in[3]; a.sinks = (const float*)d_in[4];
    a.norm_conv = (const float*)d_in[5]; a.norm_attn = (const float*)d_in[6]; a.w_out = (const float*)d_in[7]; a.norm_final = (const float*)d_in[8];
    a.out = (float*)d_out; a.ws = (unsigned char*)d_ws; a.use_cg = 0; a.pad = 0;
    void* args[] = {&a};
    hipError_t e = hipLaunchCooperativeKernel((const void*)fwd_megakernel, dim3(grid), dim3(NWAVES * 64), args, LDS_BYTES, stream);
    if (e != hipSuccess) fprintf(stderr, "cooperative launch failed: %s (grid %d)\n", hipGetErrorString(e), grid);
}
```

```cpp
#include <hip/hip_runtime.h>
#include <hip/hip_cooperative_groups.h>
#include <cstdio>
#include <cstdint>
namespace cg = cooperative_groups;

#define LAS __attribute__((address_space(3)))
#define XB_TMO      128
#define XB_XCNT(j)  (256  + 64 * (j))
#define XB_XSUB(j)  (1280 + 64 * (j))
#define XB_XGEN(j)  (2304 + 64 * (j))
#define XB_TOP      3328
#define XB_TOPGEN   3392
#define XCD_BAR_WORDS 3456
#define XB_SPIN_CAP (1u << 18)

__device__ __forceinline__ unsigned xb_ld(unsigned* p)              { return __hip_atomic_load(p, __ATOMIC_RELAXED, __HIP_MEMORY_SCOPE_AGENT); }
__device__ __forceinline__ unsigned xb_add(unsigned* p, unsigned v) { return __hip_atomic_fetch_add(p, v, __ATOMIC_RELAXED, __HIP_MEMORY_SCOPE_AGENT); }
__device__ __forceinline__ unsigned xb_xcc_id() { return (unsigned)__builtin_amdgcn_s_getreg((3 << 11) | 20) & 0xFu; }
#define XB_SPIN(cond, bar) do { unsigned _sp = 0; while (cond) { __builtin_amdgcn_s_sleep(1); \
    if ((++_sp & 255u) == 0u) { if (xb_ld(&(bar)[XB_TMO])) break; if (_sp > XB_SPIN_CAP) { atomicAdd(&(bar)[XB_TMO], 1u); break; } } } } while (0)

struct XcdBarrier {
    unsigned* bar; unsigned x;
    volatile LAS unsigned* st;
};

__device__ __forceinline__ XcdBarrier xcd_barrier_post(unsigned* bar, volatile LAS unsigned* st) {
    XcdBarrier b; b.bar = bar; b.x = xb_xcc_id(); b.st = st;
    if (threadIdx.x == 0) (void)xb_add(&bar[XB_XCNT(b.x)], 1u);
    return b;
}
__device__ __forceinline__ void xcd_barrier_complete(unsigned* bar, unsigned x, unsigned& nloc, unsigned& nx) {
    const unsigned G = gridDim.x * gridDim.y * gridDim.z;
    unsigned sum, cnt, mine, sp = 0u;
    for (;;) {
        sum = 0u; cnt = 0u; mine = 0u;
#pragma unroll
        for (unsigned j = 0; j < 16; ++j) { const unsigned c = xb_ld(&bar[XB_XCNT(j)]); sum += c; cnt += (c > 0u) ? 1u : 0u; mine = (j == x) ? c : mine; }
        if (sum == G) break;
        __builtin_amdgcn_s_sleep(1);
        if ((++sp & 255u) == 0u) { if (xb_ld(&bar[XB_TMO])) break; if (sp > XB_SPIN_CAP) { atomicAdd(&bar[XB_TMO], 1u); break; } }
    }
    nloc = mine > 0u ? mine : 1u; nx = cnt > 0u ? cnt : 1u;
}

__device__ __forceinline__ void xcd_barrier(const XcdBarrier& b) {
    asm volatile("s_waitcnt vmcnt(0)" ::: "memory");
    __syncthreads();
    if (threadIdx.x == 0) {
        unsigned* bar = b.bar;
        __builtin_amdgcn_s_waitcnt(0);
        unsigned nloc = b.st[0], nx = b.st[1];
        if (nloc == 0u) { xcd_barrier_complete(bar, b.x, nloc, nx); b.st[0] = nloc; b.st[1] = nx; }
        const unsigned old = xb_add(&bar[XB_XSUB(b.x)], 1u);
        const unsigned gen = old / nloc;
        if (old + 1u == (gen + 1u) * nloc) {
            __builtin_amdgcn_fence(__ATOMIC_RELEASE, "agent");
            asm volatile("s_waitcnt vmcnt(0)" ::: "memory");
            const unsigned og = xb_add(&bar[XB_TOP], 1u);
            const unsigned tg = og / nx;
            if (og + 1u == (tg + 1u) * nx) xb_add(&bar[XB_TOPGEN], 1u);
            else XB_SPIN(xb_ld(&bar[XB_TOPGEN]) == tg, bar);
            __builtin_amdgcn_fence(__ATOMIC_ACQUIRE, "agent");
            xb_add(&bar[XB_XGEN(b.x)], 1u);
            asm volatile("s_waitcnt vmcnt(0)" ::: "memory");
        } else {
            XB_SPIN(xb_ld(&bar[XB_XGEN(b.x)]) == gen, bar);
            __builtin_amdgcn_fence(__ATOMIC_ACQUIRE, "agent");
            asm volatile("s_waitcnt vmcnt(0)" ::: "memory");
        }
    }
    __syncthreads();
}

typedef unsigned wt_u32x4 __attribute__((ext_vector_type(4)));
typedef float wt_f32x4 __attribute__((ext_vector_type(4)));
__device__ __forceinline__ void st_wt16(void* p, wt_u32x4 v) { asm volatile("global_store_dwordx4 %0, %1, off sc1\n\ts_nop 1" :: "v"(p), "v"(v) : "memory"); }
__device__ __forceinline__ void st_wt16f(void* p, wt_f32x4 v) { asm volatile("global_store_dwordx4 %0, %1, off sc1\n\ts_nop 1" :: "v"(p), "v"(v) : "memory"); }
namespace pg8 {
#define PG8_LAS __attribute__((address_space(3)))
typedef unsigned short bf16_t;
typedef short bf16x8 __attribute__((ext_vector_type(8)));
typedef float f32x4 __attribute__((ext_vector_type(4)));
typedef unsigned u32x4 __attribute__((ext_vector_type(4)));
constexpr int BM = 256, BK = 64, HALF = 128, HTB = HALF * BK * 2  , STAGE_BYTES = 8 * HTB, NXCD = 8, WGM = 8;

__host__ __device__ __forceinline__ int lds_byte(int r, int c) { const int st = (r >> 4) * 2 + (c >> 5), rr = r & 15, cc = c & 31, ob = rr * 64 + cc * 2; return st * 1024 + (ob ^ (((ob >> 9) & 1) << 5)); }
__host__ __device__ __forceinline__ void stage_rc(int b, int& R, int& C) { const int st = b / 1024, sb = b % 1024, swz = sb ^ (((sb >> 9) & 1) << 5); R = (st >> 1) * 16 + swz / 64; C = (st & 1) * 32 + (swz % 64) / 2; }
__host__ __device__ __forceinline__ int perm32(int rho) { const int n = rho >> 4, i = rho & 15; return 8 * (i >> 2) + 4 * n + (i & 3); }

struct Unit { int pm, pn; };
struct Gemm { const bf16_t* A; const bf16_t* Bt; int M, N, K; };

struct StaticOrder {
    int nM, nN, nwg, G, c, base, lim;
    __host__ __device__ void init(int M, int N, int G_, int c_) { nM = M / BM; nN = N / BM; nwg = nM * nN; G = G_; c = c_; base = 0; lim = nwg; }
    __host__ __device__ void window(int b, int l) { base = b; lim = l; }
    __host__ __device__ bool next(int i, Unit& u) const {
        const long L = (long)base + (long)i * G + c; if (L >= lim) return false;
        int wgid = (int)L; { const int q = nwg / NXCD, r = nwg % NXCD, xcd = wgid % NXCD, off = wgid / NXCD; wgid = (xcd < r ? xcd * (q + 1) : r * (q + 1) + (xcd - r) * q) + off; }
        const int nig = WGM * nN, gid = wgid / nig, fm = gid * WGM, gsz = (nM - fm) < WGM ? (nM - fm) : WGM;
        u.pm = fm + ((wgid % nig) % gsz); u.pn = (wgid % nig) / gsz; return true;
    }
    __device__ __forceinline__ void a_ready(const Unit&) const {}
    __device__ __forceinline__ void done(const Unit&) const {}
};

struct ArriveOrder : StaticOrder {
    unsigned* cnt; int first_pn;
    __device__ __forceinline__ void done(const Unit& u) const {
        if (cnt != nullptr && u.pn == first_pn) {
            asm volatile("s_waitcnt vmcnt(0)" ::: "memory");
            if ((threadIdx.x & 63) == 0) __hip_atomic_fetch_add(cnt, 1u, __ATOMIC_RELAXED, __HIP_MEMORY_SCOPE_AGENT);
        }
    }
};

__device__ __forceinline__ unsigned cvt_pk_bf16(float lo, float hi) { unsigned r; asm volatile("v_cvt_pk_bf16_f32 %0, %1, %2" : "=v"(r) : "v"(lo), "v"(hi)); return r; }
typedef unsigned u32x2 __attribute__((ext_vector_type(2)));
constexpr float RMS_EPS = 1e-5f;
__device__ __forceinline__ float silu_f(float g) { return g * __builtin_amdgcn_rcpf(1.0f + __builtin_amdgcn_exp2f(-1.4426950408889634f * g)); }

struct EpiInProj {
    static constexpr bool PERM = false, AFTER_DRAIN = false, MID = false, XPF = false;
    bf16_t *MIX, *QKVG; const float *conv_w, *gain_c; float *SSCT, *HALO, *DEF;
    __device__ __forceinline__ void begin(const Unit& u, PG8_LAS unsigned char* lds) const {}
    __device__ __forceinline__ void mid(f32x4 (&acc)[2][2][4][2], const Unit& u, int wr, int fr, PG8_LAS unsigned char* lds) const {}
    __device__ __forceinline__ void operator()(f32x4 (&acc)[2][2][4][2], const Unit& u, int wr, int wc, int fr, int fq, PG8_LAS unsigned char* lds) const {
        if (u.pn >= 9) {
            const int lane = threadIdx.x & 63, j = u.pn - 9, col = j * 64 + wc * 16 + fq * 4;
            PG8_LAS f32x4* XB = (PG8_LAS f32x4*)(lds + STAGE_BYTES + 2048);
#pragma unroll
            for (int ai = 0; ai < 2; ++ai)
#pragma unroll
                for (int m = 0; m < 4; ++m) acc[ai][0][m][1] *= acc[ai][1][m][0];
            if (fr >= 14) {
#pragma unroll
                for (int ai = 0; ai < 2; ++ai) XB[((2 * ai + wr) * 4 + wc) * 8 + fq * 2 + (fr - 14)] = acc[ai][0][3][1];
                if (wr == 1) st_wt16f(HALO + ((size_t)u.pm * 2 + (fr - 14)) * 1024 + col, acc[1][0][3][1]);
            }
            asm volatile("s_waitcnt lgkmcnt(0)" ::: "memory"); __builtin_amdgcn_s_barrier(); asm volatile("" ::: "memory");
            const f32x4 w0 = *(const f32x4*)(conv_w + col), w1 = *(const f32x4*)(conv_w + 1024 + col), w2 = *(const f32x4*)(conv_w + 2048 + col), gn = *(const f32x4*)(gain_c + col);
            const bool deferred_tile = (u.pm & 7) != 0;
#pragma unroll
            for (int ai = 0; ai < 2; ++ai) {
                const int g = 2 * ai + wr;
                f32x4 prev = (f32x4){0.f, 0.f, 0.f, 0.f};
                if (g >= 1) prev = XB[((g - 1) * 4 + wc) * 8 + fq * 2 + (fr & 1)];
#pragma unroll
                for (int m = 0; m < 4; ++m) {
                    const f32x4 uc = acc[ai][0][m][1], cb = acc[ai][0][m][0], gt = acc[ai][1][m][1];
                    f32x4 v1, v2;
#pragma unroll
                    for (int i = 0; i < 4; ++i) {
                        const float s1 = (fr == 15) ? prev[i] : uc[i], s2 = (fr >= 14) ? prev[i] : uc[i];
                        v1[i] = __int_as_float(__builtin_amdgcn_mov_dpp(__float_as_int(s1), 0x121, 0xf, 0xf, true));
                        v2[i] = __int_as_float(__builtin_amdgcn_mov_dpp(__float_as_int(s2), 0x122, 0xf, 0xf, true));
                    }
                    const f32x4 raw = cb * (w0 * v2 + w1 * v1 + w2 * uc);
                    float ss = (raw[0] * raw[0] + raw[1] * raw[1]) + (raw[2] * raw[2] + raw[3] * raw[3]);
                    ss += __shfl_xor(ss, 16); ss += __shfl_xor(ss, 32);
                    const int rl = ai * HALF + wr * 64 + m * 16 + fr;
                    const bool def = deferred_tile && (rl < 2);
                    if (fq == 0) SSCT[((size_t)u.pm * 64 + j * 4 + wc) * 256 + rl] = def ? 0.f : ss;
                    u32x2 z;
                    z.x = cvt_pk_bf16(raw[0] * gn[0] * silu_f(gt[0]), raw[1] * gn[1] * silu_f(gt[1]));
                    z.y = cvt_pk_bf16(raw[2] * gn[2] * silu_f(gt[2]), raw[3] * gn[3] * silu_f(gt[3]));
                    *(u32x2*)(MIX + (size_t)(u.pm * BM + rl) * 2048 + col) = z;
                    if (def) { float* d = DEF + ((size_t)(u.pm * 2 + rl) * 3) * 1024 + col; st_wt16f(d, cb); st_wt16f(d + 1024, uc); st_wt16f(d + 2048, gt); }
                    prev = uc;
                }
            }
        } else {
            const int row0 = u.pm * BM + wr * 64 + fr;
            const int col = u.pn * 256 + wc * 32 + fq * 8;
            const float qs = (u.pn < 4) ? 0.125f * 1.4426950408889634f : 1.0f;
#pragma unroll
            for (int ai = 0; ai < 2; ++ai)
#pragma unroll
                for (int m = 0; m < 4; ++m) {
                    bf16_t* rowp = QKVG + (size_t)(row0 + ai * HALF + m * 16) * 2304 + col;
#pragma unroll
                    for (int bj = 0; bj < 2; ++bj) {
                        const f32x4 v0 = acc[ai][bj][m][0] * qs, v1 = acc[ai][bj][m][1] * qs;
                        u32x4 w; w.x = cvt_pk_bf16(v0[0], v0[1]); w.y = cvt_pk_bf16(v0[2], v0[3]); w.z = cvt_pk_bf16(v1[0], v1[1]); w.w = cvt_pk_bf16(v1[2], v1[3]);
                        st_wt16(rowp + bj * HALF, w);
                    }
                }
        }
    }
};

struct EpiOut {
    static constexpr bool PERM = false, AFTER_DRAIN = false, MID = true, XPF = false;
    const float* x; float* out; const float* SSC; const float* SSA; float* SSF;
    __device__ __forceinline__ void begin(const Unit& u, PG8_LAS unsigned char* lds) const {
        if (threadIdx.x < 256) { const int row = u.pm * BM + threadIdx.x;
            const float* pc = SSC + (size_t)u.pm * 64 * 256 + threadIdx.x;
            const f32x4 av0 = *(const f32x4*)(SSA + 8 * (size_t)row), av1 = *(const f32x4*)(SSA + 8 * (size_t)row + 4);
            float pv[64];
#pragma unroll
            for (int k = 0; k < 64; ++k) pv[k] = pc[k * 256];
            float c4[4] = {0.f, 0.f, 0.f, 0.f};
#pragma unroll
            for (int k = 0; k < 64; ++k) c4[k & 3] += pv[k];
            const float c = (c4[0] + c4[1]) + (c4[2] + c4[3]);
            const f32x4 av = av0 + av1; const float a = (av[0] + av[1]) + (av[2] + av[3]);
            ((PG8_LAS float*)(lds + STAGE_BYTES))[threadIdx.x] = __builtin_amdgcn_rsqf(c * (1.0f / 1024.0f) + RMS_EPS) * __builtin_amdgcn_sqrtf(a * (1.0f / 1024.0f) + RMS_EPS); }
    }
    __device__ __forceinline__ void mid(f32x4 (&acc)[2][2][4][2], const Unit& u, int wr, int fr, PG8_LAS unsigned char* lds) const {
        const PG8_LAS float* tab = (const PG8_LAS float*)(lds + STAGE_BYTES) + wr * 64 + fr;
#pragma unroll
        for (int ai = 0; ai < 2; ++ai)
#pragma unroll
            for (int m = 0; m < 4; ++m) {
                const float s = tab[ai * HALF + m * 16];
#pragma unroll
                for (int bj = 0; bj < 2; ++bj)
#pragma unroll
                    for (int n = 0; n < 2; ++n) acc[ai][bj][m][n] *= s;
            }
    }
    __device__ __forceinline__ void operator()(f32x4 (&acc)[2][2][4][2], const Unit& u, int wr, int wc, int fr, int fq, PG8_LAS unsigned char* lds) const {
        const int col0 = u.pn * BM + wc * 32 + 4 * fq;
#pragma unroll
        for (int ai = 0; ai < 2; ++ai)
#pragma unroll
            for (int m = 0; m < 4; ++m) {
                const int row = u.pm * BM + ai * HALF + wr * 64 + m * 16 + fr;
                const f32x4 av = *(const f32x4*)(SSA + 8 * (size_t)row) + *(const f32x4*)(SSA + 8 * (size_t)row + 4); const float a = (av[0] + av[1]) + (av[2] + av[3]);
                const float ra = __builtin_amdgcn_rsqf(a * (1.0f / 1024.0f) + RMS_EPS);
                const size_t off = (size_t)row * 1024 + col0;
                float ss = 0.f;
#pragma unroll
                for (int bj = 0; bj < 2; ++bj)
#pragma unroll
                    for (int n = 0; n < 2; ++n) {
                        const f32x4 xv = *(const f32x4*)(x + off + bj * HALF + n * 16);
                        const f32x4 y = xv + acc[ai][bj][m][n] * ra;
                        *(f32x4*)(out + off + bj * HALF + n * 16) = y;
                        ss += (y[0] * y[0] + y[1] * y[1]) + (y[2] * y[2] + y[3] * y[3]);
                    }
                ss += __shfl_xor(ss, 16); ss += __shfl_xor(ss, 32);
                if (fq == 0) SSF[(size_t)row * 16 + u.pn * 4 + wc] = ss;
                asm volatile("" ::: "memory");
            }
    }
};

struct EpiOutFused {
    static constexpr bool PERM = false, AFTER_DRAIN = true, MID = true, XPF = true;
    const float* x; float* out; const float* SSC; const float* SSA; float* SSF; const float* gF; unsigned* pcnt; unsigned* tmo;
    __device__ __forceinline__ void begin(const Unit& u, PG8_LAS unsigned char* lds) const {
        if (threadIdx.x < 256) { const int row = u.pm * BM + threadIdx.x;
            const float* pc = SSC + (size_t)u.pm * 64 * 256 + threadIdx.x;
            const f32x4 av0 = *(const f32x4*)(SSA + 8 * (size_t)row), av1 = *(const f32x4*)(SSA + 8 * (size_t)row + 4);
            float pv[64];
#pragma unroll
            for (int k = 0; k < 64; ++k) pv[k] = pc[k * 256];
            float c4[4] = {0.f, 0.f, 0.f, 0.f};
#pragma unroll
            for (int k = 0; k < 64; ++k) c4[k & 3] += pv[k];
            const float c = (c4[0] + c4[1]) + (c4[2] + c4[3]);
            const f32x4 av = av0 + av1; const float a = (av[0] + av[1]) + (av[2] + av[3]);
            ((PG8_LAS float*)(lds + STAGE_BYTES))[threadIdx.x] = __builtin_amdgcn_rsqf(c * (1.0f / 1024.0f) + RMS_EPS) * __builtin_amdgcn_sqrtf(a * (1.0f / 1024.0f) + RMS_EPS); }
    }
    __device__ __forceinline__ void mid(f32x4 (&acc)[2][2][4][2], const Unit& u, int wr, int fr, PG8_LAS unsigned char* lds) const {
        const PG8_LAS float* tab = (const PG8_LAS float*)(lds + STAGE_BYTES) + wr * 64 + fr;
#pragma unroll
        for (int ai = 0; ai < 2; ++ai)
#pragma unroll
            for (int m = 0; m < 4; ++m) {
                const float s = tab[ai * HALF + m * 16];
#pragma unroll
                for (int bj = 0; bj < 2; ++bj)
#pragma unroll
                    for (int n = 0; n < 2; ++n) acc[ai][bj][m][n] *= s;
            }
    }
    __device__ __forceinline__ void operator()(f32x4 (&acc)[2][2][4][2], const Unit& u, int wr, int wc, int fr, int fq, PG8_LAS unsigned char* lds) const {}
    __device__ __forceinline__ void fused(f32x4 (&acc)[2][2][4][2], const Unit& u, int wr, int wc, int fr, int fq, PG8_LAS unsigned char* lds, int wid, int lane) const {
        const int col0 = u.pn * BM + wc * 32 + 4 * fq;
#pragma unroll
        for (int ai = 0; ai < 2; ++ai) {
            f32x4 xv[4][2][2]; float ra[4];
#pragma unroll
            for (int m = 0; m < 4; ++m) {
                const int row = u.pm * BM + ai * HALF + wr * 64 + m * 16 + fr;
                const size_t off = (size_t)row * 1024 + col0;
                if (ai == 0 && !(wr == 1 && m == 3)) {
                    const int slot_buf = wr ? (m == 0 ? 6 : m == 1 ? 7 : 2) : (m == 0 ? 4 : m == 1 ? 5 : m == 2 ? 0 : 1);
                    const PG8_LAS unsigned char* xb = lds + slot_buf * HTB + (fr >> 1) * 1024 + (fr & 1) * 8192;
#pragma unroll
                    for (int bj = 0; bj < 2; ++bj)
#pragma unroll
                        for (int n = 0; n < 2; ++n) xv[m][bj][n] = *(const PG8_LAS f32x4*)(xb + 16 * ((wc * 8 + fq + bj * 32 + n * 4) ^ fr));
                } else {
#pragma unroll
                for (int bj = 0; bj < 2; ++bj)
#pragma unroll
                    for (int n = 0; n < 2; ++n) xv[m][bj][n] = __builtin_nontemporal_load((const f32x4*)(x + off + bj * HALF + n * 16));
                }
                { const f32x4 av = *(const f32x4*)(SSA + 8 * (size_t)row) + *(const f32x4*)(SSA + 8 * (size_t)row + 4); ra[m] = (av[0] + av[1]) + (av[2] + av[3]); }
            }
#pragma unroll
            for (int m = 0; m < 4; ++m) {
                const int row = u.pm * BM + ai * HALF + wr * 64 + m * 16 + fr;
                const float r = __builtin_amdgcn_rsqf(ra[m] * (1.0f / 1024.0f) + RMS_EPS);
                float ss = 0.f;
#pragma unroll
                for (int bj = 0; bj < 2; ++bj)
#pragma unroll
                    for (int n = 0; n < 2; ++n) {
                        const f32x4 y = xv[m][bj][n] + acc[ai][bj][m][n] * r;
                        acc[ai][bj][m][n] = y;
                        ss += (y[0] * y[0] + y[1] * y[1]) + (y[2] * y[2] + y[3] * y[3]);
                    }
                ss += __shfl_xor(ss, 16); ss += __shfl_xor(ss, 32);
                if (fq == 0) __hip_atomic_store(SSF + (size_t)row * 16 + u.pn * 4 + wc, ss, __ATOMIC_RELAXED, __HIP_MEMORY_SCOPE_AGENT);
            }
            asm volatile("" ::: "memory");
        }
        asm volatile("s_waitcnt vmcnt(0)" ::: "memory");
        __syncthreads();
        if (threadIdx.x == 0) {
            unsigned* pc = pcnt + 64 * u.pm;
            __hip_atomic_fetch_add(pc, 1u, __ATOMIC_RELAXED, __HIP_MEMORY_SCOPE_AGENT);
            unsigned sp = 0;
            while (__hip_atomic_load(pc, __ATOMIC_RELAXED, __HIP_MEMORY_SCOPE_AGENT) < 4u) {
                __builtin_amdgcn_s_sleep(1);
                if ((++sp & 255u) == 0u) { if (xb_ld(tmo)) break; if (sp > XB_SPIN_CAP) { atomicAdd(tmo, 1u); break; } }
            }
        }
        __syncthreads();
        PG8_LAS float* tab = (PG8_LAS float*)(lds + STAGE_BYTES);
        if (threadIdx.x < 256) { const unsigned long long* p8 = (const unsigned long long*)(SSF + (size_t)(u.pm * BM + threadIdx.x) * 16);
            unsigned long long w8[8];
#pragma unroll
            for (int k = 0; k < 8; ++k) w8[k] = __hip_atomic_load(p8 + k, __ATOMIC_RELAXED, __HIP_MEMORY_SCOPE_AGENT);
            float s = 0.f;
#pragma unroll
            for (int k = 0; k < 8; ++k) s += __uint_as_float((unsigned)w8[k]) + __uint_as_float((unsigned)(w8[k] >> 32));
            tab[threadIdx.x] = __builtin_amdgcn_rsqf(s * (1.0f / 1024.0f) + RMS_EPS); }
        __syncthreads();
        f32x4 g[2][2];
#pragma unroll
        for (int bj = 0; bj < 2; ++bj)
#pragma unroll
            for (int n = 0; n < 2; ++n) g[bj][n] = *(const f32x4*)(gF + col0 + bj * HALF + n * 16);
#pragma unroll
        for (int ai = 0; ai < 2; ++ai)
#pragma unroll
            for (int m = 0; m < 4; ++m) {
                const int rl = ai * HALF + wr * 64 + m * 16 + fr;
                const float r = tab[rl];
                const size_t off = (size_t)(u.pm * BM + rl) * 1024 + col0;
#pragma unroll
                for (int bj = 0; bj < 2; ++bj)
#pragma unroll
                    for (int n = 0; n < 2; ++n) *(f32x4*)(out + off + bj * HALF + n * 16) = acc[ai][bj][m][n] * r * g[bj][n];
            }
    }
};

template <class Epi, class Sched, bool ALIGN_EPI = false, bool SP2 = false>
__device__ __forceinline__ void gemm_phase(PG8_LAS unsigned char* lds, const Gemm g, const Sched& S, const Epi& E) {
    const int tid = threadIdx.x, wid = __builtin_amdgcn_readfirstlane(tid >> 6), lane = tid & 63, wr = wid >> 2, wc = wid & 3, fr = lane & 15, fq = lane >> 4;
    const int K = g.K, nt = K / BK;
    unsigned voffA[2], voffB[2];
#pragma unroll
    for (int i = 0; i < 2; ++i) { int R, C; stage_rc(tid * 16 + i * 8192, R, C); const int Rb = Epi::PERM ? ((R & ~31) + perm32(R & 31)) : R;
        voffA[i] = (unsigned)(R * K + C) * 2u; voffB[i] = (unsigned)(Rb * K + C) * 2u; }
    unsigned voffX[2] = {0u, 0u};
    if constexpr (Epi::XPF) {
#pragma unroll
        for (int i = 0; i < 2; ++i) { const int rr = 2 * wid + i; voffX[i] = (unsigned)(rr * 1024 + 4 * (lane ^ rr)) * 4u; } }
    const size_t kstep = (size_t)(BK * 2);
    const size_t hstep = (size_t)HALF * K * 2;
    const size_t tstep = 2 * hstep;
    const unsigned ldsw = (unsigned)wid * 1024u;
    const int aoff = lds_byte(wr * 64 + fr, fq * 8), boff = lds_byte(wc * 32 + fr, fq * 8);
#define PG8_SA(b, h) (((b) * 2 + (h)) * HTB)
#define PG8_SB(b, h) ((4 + (b) * 2 + (h)) * HTB)
#define PG8_STAGE(bufoff, gbase, voff) do { _Pragma("unroll") for (int _i = 0; _i < 2; ++_i) \
        __builtin_amdgcn_global_load_lds((const unsigned*)((const char*)(gbase) + (voff)[_i]), (PG8_LAS unsigned*)(lds + (bufoff) + ldsw + _i * 8192), 16, 0, 0); } while (0)
#define PG8_LDA(dst, b, h) do { _Pragma("unroll") for (int m = 0; m < 4; ++m) _Pragma("unroll") for (int k = 0; k < 2; ++k) dst[m][k] = *(const PG8_LAS bf16x8*)(lds + PG8_SA(b, h) + aoff + m * 2048 + k * 1024); } while (0)
#define PG8_LDB(dst, b, h) do { _Pragma("unroll") for (int n = 0; n < 2; ++n) _Pragma("unroll") for (int k = 0; k < 2; ++k) dst[n][k] = *(const PG8_LAS bf16x8*)(lds + PG8_SB(b, h) + boff + n * 2048 + k * 1024); } while (0)
#define PG8_MMA(ai, bj, At, Bt) do { __builtin_amdgcn_s_setprio(1); _Pragma("unroll") for (int m = 0; m < 4; ++m) _Pragma("unroll") for (int n = 0; n < 2; ++n) _Pragma("unroll") for (int k = 0; k < 2; ++k) \
        acc[ai][bj][m][n] = __builtin_amdgcn_mfma_f32_16x16x32_bf16(Bt[n][k], At[m][k], acc[ai][bj][m][n], 0, 0, 0); __builtin_amdgcn_s_setprio(0); } while (0)
#define PG8_WAIT_V(n) asm volatile("s_waitcnt vmcnt(" #n ")" ::: "memory")
#define PG8_WAIT_L(n) asm volatile("s_waitcnt lgkmcnt(" #n ")" ::: "memory")
#define PG8_BAR __builtin_amdgcn_s_barrier()
#define PG8_SCHED __builtin_amdgcn_sched_barrier(0)
    Unit cur, nxt; int ui = 0;
    if (!S.next(0, cur)) return;
    f32x4 acc[2][2][4][2];
#pragma unroll
    for (int a = 0; a < 2; ++a)
#pragma unroll
        for (int b = 0; b < 2; ++b)
#pragma unroll
            for (int m = 0; m < 4; ++m)
#pragma unroll
                for (int n = 0; n < 2; ++n) acc[a][b][m][n] = (f32x4){0.f, 0.f, 0.f, 0.f};
    bf16x8 At[4][2], B0[2][2], B1[2][2];
    const char* cA = (const char*)g.A + (size_t)cur.pm * tstep; const char* cB = (const char*)g.Bt + (size_t)cur.pn * tstep;
    S.a_ready(cur);
    if constexpr (SP2) {
        PG8_STAGE(PG8_SB(0, 0), cB, voffB); PG8_STAGE(PG8_SB(0, 1), cB + hstep, voffB); PG8_STAGE(PG8_SA(0, 0), cA, voffA); PG8_STAGE(PG8_SA(0, 1), cA + hstep, voffA);
        E.begin(cur, lds);
        if (wr == 1) PG8_BAR;
        PG8_WAIT_V(2); PG8_BAR;
        PG8_STAGE(PG8_SB(1, 0), cB + kstep, voffB); PG8_STAGE(PG8_SA(1, 0), cA + kstep, voffA); PG8_STAGE(PG8_SB(1, 1), cB + hstep + kstep, voffB);
        PG8_WAIT_V(6); PG8_BAR;
    } else {
        PG8_STAGE(PG8_SB(0, 0), cB, voffB); PG8_STAGE(PG8_SA(0, 0), cA, voffA); PG8_STAGE(PG8_SB(0, 1), cB + hstep, voffB); PG8_STAGE(PG8_SA(0, 1), cA + hstep, voffA);
        E.begin(cur, lds);
        if (wr == 1) PG8_BAR;
        PG8_WAIT_V(4); PG8_BAR;
        PG8_STAGE(PG8_SB(1, 0), cB + kstep, voffB); PG8_STAGE(PG8_SA(1, 0), cA + kstep, voffA); PG8_STAGE(PG8_SB(1, 1), cB + hstep + kstep, voffB);
        PG8_WAIT_V(6); PG8_BAR;
    }
    for (;;) {
        const bool has_next = S.next(ui + 1, nxt);
        const char* nA = has_next ? (const char*)g.A + (size_t)nxt.pm * tstep : cA; const char* nB = has_next ? (const char*)g.Bt + (size_t)nxt.pn * tstep : cB;
        for (int t = 0; t < nt; t += 2) {
            if constexpr (Epi::MID) { if (t == nt / 2) E.mid(acc, cur, wr, fr, lds); }
            const bool last = (t == nt - 2);
            const char* a1 = cA + (size_t)(t + 1) * kstep;
            const char* a2 = last ? nA : cA + (size_t)(t + 2) * kstep; const char* b2 = last ? nB : cB + (size_t)(t + 2) * kstep;
            const char* a3 = a2 + kstep; const char* b3 = b2 + kstep;
            if (last && has_next) S.a_ready(nxt);
            if constexpr (SP2) {
            PG8_LDB(B0, 0, 0); PG8_LDB(B1, 0, 1); PG8_SCHED; PG8_LDA(At, 0, 0); PG8_STAGE(PG8_SA(1, 1), a1 + hstep, voffA);
            PG8_WAIT_V(8); PG8_WAIT_L(0); PG8_BAR; PG8_MMA(0, 0, At, B0); PG8_MMA(0, 1, At, B1); PG8_BAR; PG8_SCHED;
            if constexpr (Epi::XPF) {
            const bool xsel = last && !has_next;
            const char* xt = (const char*)E.x + ((size_t)cur.pm * BM * 1024 + (size_t)cur.pn * BM) * 4;
            const unsigned vB[2] = {xsel ? voffX[0] : voffB[0], xsel ? voffX[1] : voffB[1]}, vA[2] = {xsel ? voffX[0] : voffA[0], xsel ? voffX[1] : voffA[1]};
#define PG8_XR(s_) (xt + (size_t)((((s_) >> 2) * 64 + ((s_) & 3) * 16)) * 4096)
            PG8_LDA(At, 0, 1); PG8_STAGE(PG8_SB(0, 0), xsel ? PG8_XR(0) : b2, vB); PG8_STAGE(PG8_SB(0, 1), xsel ? PG8_XR(1) : b2 + hstep, vB); PG8_STAGE(PG8_SA(0, 0), xsel ? PG8_XR(2) : a2, vA);
            PG8_WAIT_V(8); PG8_WAIT_L(0); PG8_BAR; PG8_MMA(1, 0, At, B0); PG8_MMA(1, 1, At, B1); PG8_BAR; PG8_SCHED;
            PG8_LDB(B0, 1, 0); PG8_LDB(B1, 1, 1); PG8_SCHED; PG8_LDA(At, 1, 0); PG8_STAGE(PG8_SA(0, 1), xsel ? PG8_XR(3) : a2 + hstep, vA);
            PG8_WAIT_V(8); PG8_WAIT_L(0); PG8_BAR; PG8_MMA(0, 0, At, B0); PG8_MMA(0, 1, At, B1); PG8_BAR; PG8_SCHED;
            PG8_LDA(At, 1, 1); PG8_STAGE(PG8_SB(1, 0), xsel ? PG8_XR(4) : b3, vB); PG8_STAGE(PG8_SB(1, 1), xsel ? PG8_XR(5) : b3 + hstep, vB); PG8_STAGE(PG8_SA(1, 0), xsel ? PG8_XR(6) : a3, vA);
            PG8_WAIT_V(8); PG8_WAIT_L(0); PG8_BAR; PG8_MMA(1, 0, At, B0); PG8_MMA(1, 1, At, B1); PG8_BAR; PG8_SCHED;
#undef PG8_XR
            } else {
            PG8_LDA(At, 0, 1); PG8_STAGE(PG8_SB(0, 0), b2, voffB); PG8_STAGE(PG8_SB(0, 1), b2 + hstep, voffB); PG8_STAGE(PG8_SA(0, 0), a2, voffA);
            PG8_WAIT_V(8); PG8_WAIT_L(0); PG8_BAR; PG8_MMA(1, 0, At, B0); PG8_MMA(1, 1, At, B1); PG8_BAR; PG8_SCHED;
            PG8_LDB(B0, 1, 0); PG8_LDB(B1, 1, 1); PG8_SCHED; PG8_LDA(At, 1, 0); PG8_STAGE(PG8_SA(0, 1), a2 + hstep, voffA);
            PG8_WAIT_V(8); PG8_WAIT_L(0); PG8_BAR; PG8_MMA(0, 0, At, B0); PG8_MMA(0, 1, At, B1); PG8_BAR; PG8_SCHED;
            PG8_LDA(At, 1, 1); PG8_STAGE(PG8_SB(1, 0), b3, voffB); PG8_STAGE(PG8_SB(1, 1), b3 + hstep, voffB); PG8_STAGE(PG8_SA(1, 0), a3, voffA);
            PG8_WAIT_V(8); PG8_WAIT_L(0); PG8_BAR; PG8_MMA(1, 0, At, B0); PG8_MMA(1, 1, At, B1); PG8_BAR; PG8_SCHED;
            }
            } else {
            PG8_LDB(B0, 0, 0); PG8_SCHED; PG8_LDA(At, 0, 0); PG8_STAGE(PG8_SA(1, 1), a1 + hstep, voffA);
            PG8_WAIT_L(8); PG8_BAR; PG8_WAIT_L(0); PG8_MMA(0, 0, At, B0); PG8_BAR; PG8_SCHED;
            PG8_LDB(B1, 0, 1); PG8_STAGE(PG8_SB(0, 0), b2, voffB);
            PG8_BAR; PG8_WAIT_L(0); PG8_MMA(0, 1, At, B1); PG8_BAR;
            PG8_LDA(At, 0, 1); PG8_STAGE(PG8_SA(0, 0), a2, voffA);
            PG8_BAR; PG8_WAIT_L(0); PG8_MMA(1, 0, At, B0); PG8_BAR; PG8_SCHED;
            PG8_STAGE(PG8_SB(0, 1), b2 + hstep, voffB);
            PG8_WAIT_V(6); PG8_BAR; PG8_MMA(1, 1, At, B1); PG8_BAR;
            PG8_LDB(B0, 1, 0); PG8_SCHED; PG8_LDA(At, 1, 0); PG8_STAGE(PG8_SA(0, 1), a2 + hstep, voffA);
            PG8_WAIT_L(8); PG8_BAR; PG8_WAIT_L(0); PG8_MMA(0, 0, At, B0); PG8_BAR; PG8_SCHED;
            PG8_LDB(B1, 1, 1); PG8_STAGE(PG8_SB(1, 0), b3, voffB);
            PG8_BAR; PG8_WAIT_L(0); PG8_MMA(0, 1, At, B1); PG8_BAR;
            PG8_LDA(At, 1, 1); PG8_STAGE(PG8_SA(1, 0), a3, voffA);
            PG8_BAR; PG8_WAIT_L(0); PG8_MMA(1, 0, At, B0); PG8_BAR; PG8_SCHED;
            PG8_STAGE(PG8_SB(1, 1), b3 + hstep, voffB);
            PG8_WAIT_V(6); PG8_BAR; PG8_MMA(1, 1, At, B1); PG8_BAR;
            }
        }
        if constexpr (ALIGN_EPI) { if (wr == 0) PG8_BAR; }
        if constexpr (!Epi::AFTER_DRAIN) { E(acc, cur, wr, wc, fr, fq, lds); S.done(cur); }
        if (!has_next) break;
#pragma unroll
        for (int a = 0; a < 2; ++a)
#pragma unroll
            for (int b = 0; b < 2; ++b)
#pragma unroll
                for (int m = 0; m < 4; ++m)
#pragma unroll
                    for (int n = 0; n < 2; ++n) acc[a][b][m][n] = (f32x4){0.f, 0.f, 0.f, 0.f};
        cur = nxt; cA = nA; cB = nB; ++ui;
        E.begin(cur, lds);
        if constexpr (ALIGN_EPI) { if (wr == 1) PG8_BAR; }
    }
    PG8_WAIT_V(0);
    if constexpr (!ALIGN_EPI) { if (wr == 0) PG8_BAR; }
    PG8_BAR;
    if constexpr (Epi::AFTER_DRAIN) { E.fused(acc, cur, wr, wc, fr, fq, lds, wid, lane); S.done(cur); }
#undef PG8_SA
#undef PG8_SB
#undef PG8_STAGE
#undef PG8_LDA
#undef PG8_LDB
#undef PG8_MMA
#undef PG8_WAIT_V
#undef PG8_WAIT_L
#undef PG8_BAR
#undef PG8_SCHED
}
}
constexpr int M = 16384, DM = 1024, NPROJ = 6400, DMIX = 2048, SEQ = 2048;
constexpr int QP = 2304;
constexpr size_t MiB = 1u << 20;
constexpr size_t WS_SSA = 9 * MiB, WS_SSF = 512 * 1024;
constexpr size_t WS_WOUT = 2 * MiB;
constexpr size_t WS_HALO = 6 * MiB;
constexpr size_t WS_DEF = 7 * MiB;
constexpr size_t WS_WIN = 10 * MiB;
constexpr size_t WS_XN = 24 * MiB;
constexpr size_t WS_MIX = 56 * MiB;
constexpr size_t WS_QKVG = 120 * MiB;
constexpr size_t WS_SSC = 192 * MiB;
constexpr size_t WS_END = 196 * MiB;
constexpr int NWAVES = 8;
constexpr int LDS_BYTES = 147456;
typedef unsigned short bf16;
typedef unsigned v4u __attribute__((ext_vector_type(4)));
typedef unsigned v2u __attribute__((ext_vector_type(2)));
typedef float f32x4 __attribute__((ext_vector_type(4)));
typedef float f32x16 __attribute__((ext_vector_type(16)));
typedef short bf16x8 __attribute__((ext_vector_type(8)));
typedef short s16x4 __attribute__((ext_vector_type(4)));
#define LDS_WAIT() asm volatile("s_waitcnt lgkmcnt(0)" ::: "memory")
__device__ __forceinline__ unsigned pk2(float lo, float hi) { return pg8::cvt_pk_bf16(lo, hi); }
__device__ __forceinline__ float bflo(unsigned w) { return __uint_as_float(w << 16); }
__device__ __forceinline__ float bfhi(unsigned w) { return __uint_as_float(w & 0xffff0000u); }
__device__ __forceinline__ float wave_sum(float v) {
#pragma unroll
    for (int o = 1; o < 64; o <<= 1) v += __shfl_xor(v, o);
    return v;
}
__device__ __forceinline__ float silu(float g) { return g * __builtin_amdgcn_rcpf(1.0f + __builtin_amdgcn_exp2f(-1.4426950408889634f * g)); }

__device__ __forceinline__ int win_dst_row(int n) {
    if (n < 4096) { const int s = n >> 10, jc = n & 1023, j = jc >> 6, ch = jc & 63, wc = ch >> 4, fq = (ch >> 2) & 3, i = ch & 3, bj = s >> 1, nn = s & 1;
        return 2304 + 256 * j + 128 * bj + 32 * wc + 16 * nn + 4 * fq + i; }
    const int a = n - 4096, pn = a >> 8, lg = a & 255, bj = lg >> 7, wc = (lg >> 5) & 3, fq = (lg >> 3) & 3, nn = (lg >> 2) & 1, i = lg & 3;
    return 256 * pn + 128 * bj + 32 * wc + 16 * nn + 4 * fq + i;
}
template <bool PERMUTE>
__device__ __forceinline__ void p0_transpose_item(const float* W, int K, int N, bf16* WT, LAS float* scr, int item, int lane) {
    const int nblk = N / 32, kb = item / nblk, nb = item % nblk, k0 = 64 * kb, n0 = 32 * nb;
    float wv[32];
#pragma unroll
    for (int i = 0; i < 32; ++i) wv[i] = __builtin_nontemporal_load(W + (size_t)(k0 + 2 * i + (lane >> 5)) * N + n0 + (lane & 31));
#pragma unroll
    for (int i = 0; i < 32; ++i) scr[(2 * i + (lane >> 5)) * 33 + (lane & 31)] = wv[i];
    LDS_WAIT(); asm volatile("" ::: "memory");
    const int c = lane & 7;
#pragma unroll
    for (int j = 0; j < 4; ++j) { const int n = (lane >> 3) + 8 * j; const LAS float* s = scr + (8 * c) * 33 + n;
        v4u o; o.x = pk2(s[0 * 33], s[1 * 33]); o.y = pk2(s[2 * 33], s[3 * 33]); o.z = pk2(s[4 * 33], s[5 * 33]); o.w = pk2(s[6 * 33], s[7 * 33]);
        const int dr = PERMUTE ? win_dst_row(n0 + n) : (n0 + n);
        if (PERMUTE && n0 < 4096) __builtin_nontemporal_store(o, (v4u*)(WT + (size_t)dr * K + k0 + 8 * c));
        else *(v4u*)(WT + (size_t)dr * K + k0 + 8 * c) = o; }
    LDS_WAIT(); asm volatile("" ::: "memory");
}
__device__ __forceinline__ void rms_row_to_bf16(const float* xrow, const float* g, bf16* orow, int lane) {
    const f32x4* xr = (const f32x4*)xrow + lane; const f32x4* gr = (const f32x4*)g + lane;
    f32x4 v[4]; float s = 0.f;
#pragma unroll
    for (int j = 0; j < 4; ++j) { v[j] = xr[64 * j]; s += (v[j].x * v[j].x + v[j].y * v[j].y) + (v[j].z * v[j].z + v[j].w * v[j].w); }
    const float rstd = __builtin_amdgcn_rsqf(wave_sum(s) * (1.f / DM) + pg8::RMS_EPS);
    unsigned long long* o8 = (unsigned long long*)orow + lane;
#pragma unroll
    for (int j = 0; j < 4; ++j) { const f32x4 gg = gr[64 * j]; const f32x4 y = v[j] * rstd * gg;
        o8[64 * j] = (unsigned long long)pk2(y.x, y.y) | ((unsigned long long)pk2(y.z, y.w) << 32); }
}

__device__ __forceinline__ void rms_rows4_to_bf16(const float* xrow, const float* g, bf16* orow, int lane) {
    f32x4 v[4][4]; float s[4];
#pragma unroll
    for (int r = 0; r < 4; ++r) { const f32x4* xr = (const f32x4*)(xrow + (size_t)r * DM) + lane;
#pragma unroll
        for (int j = 0; j < 4; ++j) v[r][j] = __builtin_nontemporal_load(xr + 64 * j); }
#pragma unroll
    for (int r = 0; r < 4; ++r) { float t = 0.f;
#pragma unroll
        for (int j = 0; j < 4; ++j) t += (v[r][j].x * v[r][j].x + v[r][j].y * v[r][j].y) + (v[r][j].z * v[r][j].z + v[r][j].w * v[r][j].w);
        s[r] = t; }
#pragma unroll
    for (int o = 1; o < 64; o <<= 1) {
#pragma unroll
        for (int r = 0; r < 4; ++r) s[r] += __shfl_xor(s[r], o); }
    const f32x4* gr = (const f32x4*)g + lane;
#pragma unroll
    for (int r = 0; r < 4; ++r) { const float rstd = __builtin_amdgcn_rsqf(s[r] * (1.f / DM) + pg8::RMS_EPS);
        unsigned long long* o8 = (unsigned long long*)(orow + (size_t)r * DM) + lane;
#pragma unroll
        for (int j = 0; j < 4; ++j) { const f32x4 y = v[r][j] * rstd * gr[64 * j];
            o8[64 * j] = (unsigned long long)pk2(y.x, y.y) | ((unsigned long long)pk2(y.z, y.w) << 32); } }
}

constexpr int KP = 72, VP = 264;
constexpr int LDS_KS = 0, LDS_VT = 256 * KP * 2, LDS_SS = LDS_VT + 64 * VP * 2, LDS_WT = LDS_SS + 4096 + 2048;
__device__ __forceinline__ void attn_unit(LAS unsigned char* lds, int unit, int mode, const bf16* QKVG, const float* sinks, const float* gain_a, bf16* MIX, float* SSA) {
    const int tid = threadIdx.x, lane = tid & 63, w = __builtin_amdgcn_readfirstlane(tid >> 6);
    const int kvh = unit & 1, blk = unit >> 1, nblk = blk & 15, T0 = blk * 128;
    const int hl = (mode == 0) ? w : (mode <= 2) ? (4 * (mode - 1) + (w & 3)) : (2 * (mode - 3) + (w & 1));
    const int i0 = (mode == 0) ? 0 : (mode <= 2) ? 2 * (w >> 2) : (w >> 1), i1 = (mode == 0) ? 4 : (mode <= 2) ? i0 + 2 : i0 + 1;
    LAS bf16* Ks = (LAS bf16*)(lds + LDS_KS); LAS bf16* Vt = (LAS bf16*)(lds + LDS_VT); LAS float* SS = (LAS float*)(lds + LDS_SS);
    const int h = kvh * 8 + hl, q = lane & 31, hh = lane >> 5;
    SS[tid] = 0.f; SS[tid + 512] = 0.f;
    const int r8 = lane >> 3, c8 = lane & 7;
    const bf16* qrow0 = QKVG + (size_t)(T0 + r8) * QP + h * 64 + 8 * c8;
    const bf16* grow0 = qrow0 + 1280;
    LAS bf16* WT = (LAS bf16*)(lds + LDS_WT) + w * (32 * KP);
    LAS bf16* wt_row = WT + r8 * KP + 8 * c8;
    LAS bf16* wt_frq = WT + q * KP + 8 * hh;
    LAS bf16* wt_frd = WT + q * KP + 4 * hh;
    bf16x8 qr[4]; v2u gt[8]; v4u qrow[4], grow[4];
#pragma unroll
    for (int k = 0; k < 4; ++k) qrow[k] = __builtin_nontemporal_load((const v4u*)(qrow0 + (size_t)(32 * i0 + 8 * k) * QP));
    {
        const int rp = tid >> 2, qd = tid & 3, row = 2 * rp;
        const bool valid = (nblk > 0) || (row >= 128);
        const int tok = valid ? (T0 - 128 + row) : T0;
        const bf16* src = QKVG + (size_t)tok * QP + 1024 + kvh * 64 + qd * 16;
        v4u k0[2], k1[2], v0[2], v1[2];
#pragma unroll
        for (int c = 0; c < 2; ++c) { k0[c] = *(const v4u*)(src + 8 * c); k1[c] = *(const v4u*)(src + QP + 8 * c); v0[c] = *(const v4u*)(src + 128 + 8 * c); v1[c] = *(const v4u*)(src + QP + 128 + 8 * c);
            if (!valid) { k0[c] = k1[c] = v0[c] = v1[c] = (v4u){0u, 0u, 0u, 0u}; } }
#pragma unroll
        for (int c = 0; c < 2; ++c) { *(LAS v4u*)(Ks + row * KP + qd * 16 + 8 * c) = k0[c]; *(LAS v4u*)(Ks + (row + 1) * KP + qd * 16 + 8 * c) = k1[c]; }
        const int kq = row & 15, pos = (row & ~15) + (kq & 3) + 4 * ((kq >> 3) & 1) + 8 * ((kq >> 2) & 1);
#pragma unroll
        for (int c = 0; c < 2; ++c)
#pragma unroll
            for (int e = 0; e < 4; ++e) { const unsigned a = v0[c][e], b = v1[c][e];
                *(LAS unsigned*)(Vt + (qd * 16 + 8 * c + 2 * e) * VP + pos) = (a & 0xffffu) | (b << 16);
                *(LAS unsigned*)(Vt + (qd * 16 + 8 * c + 2 * e + 1) * VP + pos) = (a >> 16) | (b & 0xffff0000u); }
    }
    __syncthreads();
    constexpr float LOG2E = 1.4426950408889634f;
    const float slope2 = exp2f(-0.5f * (float)(h + 1)) * LOG2E, sink2 = sinks[h] * LOG2E;
    LAS float* GN = SS + 8 * 128 + w * 64;
    GN[lane] = gain_a[h * 64 + lane];
#pragma unroll
    for (int k = 0; k < 4; ++k) *(LAS v4u*)(wt_row + 8 * k * KP) = qrow[k];
#pragma unroll
    for (int s = 0; s < 4; ++s) qr[s] = *(const LAS bf16x8*)(wt_frq + 16 * s);
    for (int i = i0; i < i1; ++i) {
        const int inx = (i < 3) ? (i + 1) : 3;
#pragma unroll
        for (int k = 0; k < 4; ++k) qrow[k] = __builtin_nontemporal_load((const v4u*)(qrow0 + (size_t)(32 * inx + 8 * k) * QP));
#pragma unroll
        for (int k = 0; k < 4; ++k) grow[k] = __builtin_nontemporal_load((const v4u*)(grow0 + (size_t)(32 * i + 8 * k) * QP));
        int qq = q - 4 * hh; asm volatile("" : "+v"(qq));
        float base = slope2 * (float)(4 * hh); asm volatile("" : "+v"(base));
        f32x16 st[5];
#pragma unroll
        for (int j = 0; j < 5; ++j) {
            const bool tile_ok = !(nblk == 0 && (i + j) < 4);
            const float sl = tile_ok ? slope2 : 0.f, bs = tile_ok ? base : -INFINITY;
#pragma unroll
            for (int r = 0; r < 16; ++r) st[j][r] = fmaf(sl, (float)((r & 3) + 8 * (r >> 2) + 32 * j), bs);
        }
        {
            const LAS bf16* kp = Ks + (32 * i + q) * KP + hh * 8;
            bf16x8 kf[2][5];
#pragma unroll
            for (int j = 0; j < 5; ++j) kf[0][j] = *(const LAS bf16x8*)(kp + j * 32 * KP);
#pragma unroll
            for (int s = 0; s < 4; ++s) {
                if (s < 3) {
#pragma unroll
                    for (int j = 0; j < 5; ++j) kf[(s + 1) & 1][j] = *(const LAS bf16x8*)(kp + j * 32 * KP + 16 * (s + 1));
                }
#pragma unroll
                for (int j = 0; j < 5; ++j) st[j] = __builtin_amdgcn_mfma_f32_32x32x16_bf16(kf[s & 1][j], qr[s], st[j], 0, 0, 0);
            }
        }
        const float sinkq = fmaf(slope2, (float)(128 + 4 * hh) + (float)qq, sink2);
        float mx = sinkq;
#pragma unroll
        for (int r = 0; r < 16; ++r) {
            const int cr = (r & 3) + 8 * (r >> 2);
            const bool up = cr > qq;
            st[0][r] = up ? st[0][r] : -INFINITY;
            st[4][r] = up ? -INFINITY : st[4][r];
        }
#pragma unroll
        for (int j = 0; j < 5; ++j)
#pragma unroll
            for (int r = 0; r < 16; ++r) mx = fmaxf(mx, st[j][r]);
        mx = fmaxf(mx, __shfl_xor(mx, 32));
        float sum = 0.f;
#pragma unroll
        for (int j = 0; j < 5; ++j)
#pragma unroll
            for (int r = 0; r < 16; ++r) { const float p = __builtin_amdgcn_exp2f(st[j][r] - mx); st[j][r] = p; sum += p; }
        sum += __shfl_xor(sum, 32);
        sum += __builtin_amdgcn_exp2f(sinkq - mx);
        const float inv = __builtin_amdgcn_rcpf(sum);
        f32x16 ot[2]; ot[0] = f32x16{}; ot[1] = f32x16{};
#pragma unroll
        for (int j = 0; j < 5; ++j)
#pragma unroll
            for (int s2 = 0; s2 < 2; ++s2) {
                v4u pw; pw.x = pk2(st[j][8 * s2 + 0], st[j][8 * s2 + 1]); pw.y = pk2(st[j][8 * s2 + 2], st[j][8 * s2 + 3]);
                pw.z = pk2(st[j][8 * s2 + 4], st[j][8 * s2 + 5]); pw.w = pk2(st[j][8 * s2 + 6], st[j][8 * s2 + 7]);
                const bf16x8 pf = __builtin_bit_cast(bf16x8, pw);
#pragma unroll
                for (int db = 0; db < 2; ++db) {
                    const bf16x8 vf = *(const LAS bf16x8*)(Vt + (db * 32 + q) * VP + 32 * (i + j) + 16 * s2 + 8 * hh);
                    ot[db] = __builtin_amdgcn_mfma_f32_32x32x16_bf16(vf, pf, ot[db], 0, 0, 0);
                }
            }
        float ss = 0.f;
#pragma unroll
        for (int k = 0; k < 4; ++k) *(LAS v4u*)(wt_row + 8 * k * KP) = grow[k];
#pragma unroll
        for (int e = 0; e < 8; ++e) gt[e] = *(const LAS v2u*)(wt_frd + 32 * (e >> 2) + 8 * (e & 3));
#pragma unroll
        for (int e = 0; e < 8; ++e) {
            const int db = e >> 2, g4 = e & 3;
            const float o0 = ot[db][4 * g4 + 0] * inv, o1 = ot[db][4 * g4 + 1] * inv, o2 = ot[db][4 * g4 + 2] * inv, o3 = ot[db][4 * g4 + 3] * inv;
            ss += (o0 * o0 + o1 * o1) + (o2 * o2 + o3 * o3);
            const f32x4 gn = *(const LAS f32x4*)(GN + 4 * hh + 32 * db + 8 * g4);
            v2u z; z.x = pk2(o0 * gn[0] * silu(bflo(gt[e].x)), o1 * gn[1] * silu(bfhi(gt[e].x)));
            z.y = pk2(o2 * gn[2] * silu(bflo(gt[e].y)), o3 * gn[3] * silu(bfhi(gt[e].y)));
            *(LAS v2u*)(wt_frd + 32 * db + 8 * g4) = z;
        }
        {
            bf16* orow0 = MIX + (size_t)(T0 + 32 * i + r8) * DMIX + 1024 + h * 64 + 8 * c8;
#pragma unroll
            for (int k = 0; k < 4; ++k) { const v4u v = *(const LAS v4u*)(wt_row + 8 * k * KP); *(v4u*)(orow0 + (size_t)(8 * k) * DMIX) = v; }
        }
#pragma unroll
        for (int k = 0; k < 4; ++k) *(LAS v4u*)(wt_row + 8 * k * KP) = qrow[k];
        ss += __shfl_xor(ss, 32);
        if (hh == 0) SS[w * 128 + 32 * i + q] = ss;
#pragma unroll
        for (int s = 0; s < 4; ++s) qr[s] = *(const LAS bf16x8*)(wt_frq + 16 * s);
    }
    __syncthreads();
    if (tid < 128) { float s = 0.f;
#pragma unroll
        for (int ww = 0; ww < 8; ++ww) s += SS[ww * 128 + tid];
        float* sa = SSA + (size_t)(T0 + tid) * 8 + kvh * 4;
        if (mode == 0) *(f32x4*)sa = (f32x4){s, 0.f, 0.f, 0.f};
        else if (mode <= 2) { sa[2 * (mode - 1)] = s; sa[2 * (mode - 1) + 1] = 0.f; }
        else sa[mode - 3] = s; }
    __syncthreads();
}

__device__ __forceinline__ void conv_fixup(int idx, int lane, const float* DEF, const float* HALO, const float* conv_w, const float* gain_c, bf16* MIX, float* SSC) {
    const int pm = idx >> 1, rho = idx & 1;
    if ((pm & 7) == 0) return;
    const int c = lane * 16, t = pm * 256 + rho;
    const float* d = DEF + ((size_t)(pm * 2 + rho) * 3) * 1024 + c;
    const float* p1 = rho ? (DEF + ((size_t)(pm * 2) * 3 + 1) * 1024 + c) : (HALO + ((size_t)(pm - 1) * 2 + 1) * 1024 + c);
    const float* p2 = rho ? (HALO + ((size_t)(pm - 1) * 2 + 1) * 1024 + c) : (HALO + ((size_t)(pm - 1) * 2) * 1024 + c);
    float ss = 0.f; unsigned zw[8];
#pragma unroll
    for (int e4 = 0; e4 < 4; ++e4) {
        const f32x4 cb = *(const f32x4*)(d + 4 * e4), u0 = *(const f32x4*)(d + 1024 + 4 * e4), g = *(const f32x4*)(d + 2048 + 4 * e4), u1 = *(const f32x4*)(p1 + 4 * e4), u2 = *(const f32x4*)(p2 + 4 * e4);
        const f32x4 w0 = *(const f32x4*)(conv_w + c + 4 * e4), w1 = *(const f32x4*)(conv_w + 1024 + c + 4 * e4), w2 = *(const f32x4*)(conv_w + 2048 + c + 4 * e4), gn = *(const f32x4*)(gain_c + c + 4 * e4);
        const f32x4 raw = cb * (w0 * u2 + w1 * u1 + w2 * u0);
        ss += (raw[0] * raw[0] + raw[1] * raw[1]) + (raw[2] * raw[2] + raw[3] * raw[3]);
        zw[2 * e4] = pk2(raw[0] * gn[0] * silu(g[0]), raw[1] * gn[1] * silu(g[1])); zw[2 * e4 + 1] = pk2(raw[2] * gn[2] * silu(g[2]), raw[3] * gn[3] * silu(g[3]));
    }
    *(v4u*)(MIX + (size_t)t * DMIX + c) = (v4u){zw[0], zw[1], zw[2], zw[3]}; *(v4u*)(MIX + (size_t)t * DMIX + c + 8) = (v4u){zw[4], zw[5], zw[6], zw[7]};
    ss = wave_sum(ss); if (lane == 0) SSC[(size_t)pm * 64 * 256 + rho] = ss;
}

__device__ __forceinline__ void group_arrive(unsigned* cnt) {
    asm volatile("s_waitcnt vmcnt(0)" ::: "memory");
    __syncthreads();
    if (threadIdx.x == 0) __hip_atomic_fetch_add(cnt, 1u, __ATOMIC_RELAXED, __HIP_MEMORY_SCOPE_AGENT);
}
__device__ __forceinline__ void group_wait(unsigned* cnt, unsigned want, unsigned* bar) {
    if (threadIdx.x == 0) {
        unsigned sp = 0;
        while (__hip_atomic_load(cnt, __ATOMIC_RELAXED, __HIP_MEMORY_SCOPE_AGENT) < want) {
            __builtin_amdgcn_s_sleep(2);
            if ((++sp & 255u) == 0u) { if (xb_ld(&bar[XB_TMO])) break; if (sp > XB_SPIN_CAP) { atomicAdd(&bar[XB_TMO], 1u); break; } }
        }
        __builtin_amdgcn_fence(__ATOMIC_ACQUIRE, "agent");
        asm volatile("s_waitcnt vmcnt(0)" ::: "memory");
    }
    __syncthreads();
}

constexpr size_t WS_BAR = 1536 * 1024;
constexpr int LDS_TAB = 131072, LDS_MISC = LDS_TAB + 1024;
struct Args { const float *x, *norm_in, *w_in, *conv_w, *sinks, *norm_conv, *norm_attn, *w_out, *norm_final; float* out; unsigned char* ws; int use_cg; int pad; };
__global__ void __launch_bounds__(NWAVES * 64, 2) fwd_megakernel(Args a) {
    extern __shared__ __attribute__((aligned(16))) unsigned char lds_raw[];
    LAS unsigned char* lds = (LAS unsigned char*)lds_raw;
    const int tid = threadIdx.x, lane = tid & 63, wave = __builtin_amdgcn_readfirstlane(tid >> 6);
    const int G = gridDim.x, gw = blockIdx.x * NWAVES + wave, NGW = G * NWAVES;
    unsigned char* ws = a.ws;
    float* SSC = (float*)(ws + WS_SSC); float* SSA = (float*)(ws + WS_SSA); float* SSF = (float*)(ws + WS_SSF);
    bf16* WOUT = (bf16*)(ws + WS_WOUT); bf16* WIN = (bf16*)(ws + WS_WIN); bf16* XN = (bf16*)(ws + WS_XN); bf16* MIX = (bf16*)(ws + WS_MIX);
    bf16* QKVG = (bf16*)(ws + WS_QKVG); float* HALO = (float*)(ws + WS_HALO); float* DEF = (float*)(ws + WS_DEF);
    if (a.use_cg) cg::this_grid().sync();
    volatile LAS unsigned* MISC = (volatile LAS unsigned*)(lds + LDS_MISC);
    if (tid < 32) MISC[tid] = 0u;
    __syncthreads();
    const XcdBarrier bar = xcd_barrier_post((unsigned*)(ws + WS_BAR), MISC + 8);

    {
        LAS float* scr = (LAS float*)(lds + wave * 16384);
        constexpr int I_IN = (DM / 64) * (NPROJ / 32);
        if (G == 256) {
            { const int kb = gw >> 7, nb = gw & 127; p0_transpose_item<true>(a.w_in, DM, NPROJ, WIN, scr, kb * (NPROJ / 32) + nb, lane); }
            if (gw < 1152) { const int kb = gw / 72, nb = 128 + gw % 72; p0_transpose_item<true>(a.w_in, DM, NPROJ, WIN, scr, kb * (NPROJ / 32) + nb, lane); }
        } else
        for (int it = gw; it < I_IN; it += NGW) p0_transpose_item<true>(a.w_in, DM, NPROJ, WIN, scr, it, lane);
        for (int m = gw * 4; m < M; m += NGW * 4) rms_rows4_to_bf16(a.x + (size_t)m * DM, a.norm_in, XN + (size_t)m * DM, lane);
    }
    xcd_barrier(bar);
    {
        pg8::Gemm g{XN, WIN, M, NPROJ, DM}; pg8::ArriveOrder S; S.init(M, NPROJ, G, (int)blockIdx.x);
        pg8::EpiInProj E{MIX, QKVG, a.conv_w, a.norm_conv, SSC, HALO, DEF};
        const bool flow = (G == 256);
        unsigned* gca = (unsigned*)(ws + WS_BAR) + 4096 + 64 * (blockIdx.x & 7);
        unsigned* gcc = (unsigned*)(ws + WS_BAR) + 8192 + 64 * (blockIdx.x & 7);
        S.cnt = flow ? gca : nullptr; S.first_pn = (blockIdx.x < 64) ? 12 : 8 + (int)(blockIdx.x >> 6);
        pg8::gemm_phase<pg8::EpiInProj, pg8::ArriveOrder, true, true>(lds, g, S, E);
        if (flow) {
            group_arrive(gcc);
            const int gb = blockIdx.x & 7, l = blockIdx.x >> 3;
            if (l >= 8) {
                group_wait(gca, 256u, (unsigned*)(ws + WS_BAR));
                attn_unit(lds, gb * 32 + l, 0, QKVG, a.sinks, a.norm_attn, MIX, SSA);
                {
                    LAS float* scr = (LAS float*)(lds + wave * 16384);
                    constexpr int I_OUT = (DMIX / 64) * (DM / 32);
                    const int it = ((blockIdx.x & 7) * 24 + (l - 8)) * NWAVES + wave;
                    if (it < I_OUT) p0_transpose_item<false>(a.w_out, DMIX, DM, WOUT, scr, it, lane);
                    __syncthreads();
                }
            } else group_wait(gca, 256u, (unsigned*)(ws + WS_BAR));
            attn_unit(lds, gb * 32 + (l >> 2), 3 + (l & 3), QKVG, a.sinks, a.norm_attn, MIX, SSA);
            if (l >= 24) {
                group_wait(gcc, 32u, (unsigned*)(ws + WS_BAR));
                if (l != 24 && wave < 2) conv_fixup(2 * (gb * 8 + (l - 24)) + wave, lane, DEF, HALO, a.conv_w, a.norm_conv, MIX, SSC);
            }
        } else {
            xcd_barrier(bar);
            for (int unit = blockIdx.x; unit < 256; unit += G) attn_unit(lds, unit, 0, QKVG, a.sinks, a.norm_attn, MIX, SSA);
            for (int idx = gw; idx < 128; idx += NGW) conv_fixup(idx, lane, DEF, HALO, a.conv_w, a.norm_conv, MIX, SSC);
            LAS float* scr = (LAS float*)(lds + wave * 16384);
            constexpr int I_OUT = (DMIX / 64) * (DM / 32);
            for (int it = gw; it < I_OUT; it += NGW) p0_transpose_item<false>(a.w_out, DMIX, DM, WOUT, scr, it, lane);
        }
    }
    xcd_barrier(bar);
    if (G == 256) {
        pg8::Gemm g{MIX, WOUT, M, DM, DMIX}; pg8::StaticOrder S; S.init(M, DM, G, (int)blockIdx.x);
        pg8::EpiOutFused E{a.x, a.out, SSC, SSA, SSF, a.norm_final, (unsigned*)(ws + WS_BAR) + 12288, (unsigned*)(ws + WS_BAR) + XB_TMO};
        pg8::gemm_phase<pg8::EpiOutFused, pg8::StaticOrder, false, true>(lds, g, S, E);
    } else {
        {
            pg8::Gemm g{MIX, WOUT, M, DM, DMIX}; pg8::StaticOrder S; S.init(M, DM, G, (int)blockIdx.x);
            pg8::EpiOut E{a.x, a.out, SSC, SSA, SSF};
            pg8::gemm_phase<pg8::EpiOut, pg8::StaticOrder, true, true>(lds, g, S, E);
        }
        xcd_barrier(bar);
        for (int m = gw; m < M; m += NGW) {
            float s = SSF[(size_t)m * 16 + (lane & 15)];
            s += __shfl_xor(s, 1); s += __shfl_xor(s, 2); s += __shfl_xor(s, 4); s += __shfl_xor(s, 8);
            const float rstd = __builtin_amdgcn_rsqf(s * (1.f / DM) + pg8::RMS_EPS);
            f32x4* o = (f32x4*)(a.out + (size_t)m * DM) + lane; const f32x4* gf = (const f32x4*)a.norm_final + lane;
#pragma unroll
            for (int j = 0; j < 4; ++j) o[64 * j] = o[64 * j] * rstd * gf[64 * j];
        }
    }
}

extern "C" void kernel_launch(void* const* d_in, const int* in_sizes, int n_in, void* d_out, int out_size, void* d_ws, size_t ws_size, hipStream_t stream) {
    static int grid = 0;
    if (grid == 0) {
        if (n_in != 9 || in_sizes[0] != M * DM || out_size != M * DM || ws_size < WS_END) { fprintf(stderr, "kernel_launch: unexpected shapes (n_in %d in0 %d out %d ws %zu)\n", n_in, n_in > 0 ? in_sizes[0] : -1, out_size, ws_size); grid = -1; return; }
        int dev = 0, cus = 0, per_cu = 0;
        (void)hipGetDevice(&dev); (void)hipDeviceGetAttribute(&cus, hipDeviceAttributeMultiprocessorCount, dev);
        if (hipFuncSetAttribute((const void*)fwd_megakernel, hipFuncAttributeMaxDynamicSharedMemorySize, LDS_BYTES) != hipSuccess) { fprintf(stderr, "kernel_launch: hipFuncSetAttribute failed\n"); grid = -1; return; }
        if (hipOccupancyMaxActiveBlocksPerMultiprocessor(&per_cu, (const void*)fwd_megakernel, NWAVES * 64, LDS_BYTES) != hipSuccess || per_cu < 1) { fprintf(stderr, "kernel_launch: occupancy query says %d\n", per_cu); per_cu = 1; }
        (void)hipGetLastError();
        grid = cus * 1;
    }
    if (grid < 0) return;
    (void)hipMemsetAsync((unsigned char*)d_ws + WS_BAR, 0, 65536, stream);
    Args a{};
    a.x = (const float*)d_in[0]; a.norm_in = (const float*)d_in[1]; a.w_in = (const float*)d_in[2]; a.conv_w = (const float*)d_in[3]; a.sinks = (const float*)d_in[4];
    a.norm_conv = (const float*)d_in[5]; a.norm_attn = (const float*)d_in[6]; a.w_out = (const float*)d_in[7]; a.norm_final = (const float*)d_in[8];
    a.out = (float*)d_out; a.ws = (unsigned char*)d_ws; a.use_cg = 0; a.pad = 0;
    void* args[] = {&a};
    hipError_t e = hipLaunchCooperativeKernel((const void*)fwd_megakernel, dim3(grid), dim3(NWAVES * 64), args, LDS_BYTES, stream);
    if (e != hipSuccess) fprintf(stderr, "cooperative launch failed: %s (grid %d)\n", hipGetErrorString(e), grid);
}
```

```cpp
#include <hip/hip_runtime.h>
#include <hip/hip_cooperative_groups.h>
#include <cstdio>
#include <cstdint>
namespace cg = cooperative_groups;

#define LAS __attribute__((address_space(3)))
#define XB_TMO      128
#define XB_XCNT(j)  (256  + 64 * (j))
#define XB_XSUB(j)  (1280 + 64 * (j))
#define XB_XGEN(j)  (2304 + 64 * (j))
#define XB_TOP      3328
#define XB_TOPGEN   3392
#define XCD_BAR_WORDS 3456
#define XB_SPIN_CAP (1u << 18)

__device__ __forceinline__ unsigned xb_ld(unsigned* p)              { return __hip_atomic_load(p, __ATOMIC_RELAXED, __HIP_MEMORY_SCOPE_AGENT); }
__device__ __forceinline__ unsigned xb_add(unsigned* p, unsigned v) { return __hip_atomic_fetch_add(p, v, __ATOMIC_RELAXED, __HIP_MEMORY_SCOPE_AGENT); }
__device__ __forceinline__ unsigned xb_xcc_id() { return (unsigned)__builtin_amdgcn_s_getreg((3 << 11) | 20) & 0xFu; }
#define XB_SPIN(cond, bar) do { unsigned _sp = 0; while (cond) { __builtin_amdgcn_s_sleep(1); \
    if ((++_sp & 255u) == 0u) { if (xb_ld(&(bar)[XB_TMO])) break; if (_sp > XB_SPIN_CAP) { atomicAdd(&(bar)[XB_TMO], 1u); break; } } } } while (0)

struct XcdBarrier {
    unsigned* bar; unsigned x;
    volatile LAS unsigned* st;
};

__device__ __forceinline__ XcdBarrier xcd_barrier_post(unsigned* bar, volatile LAS unsigned* st) {
    XcdBarrier b; b.bar = bar; b.x = xb_xcc_id(); b.st = st;
    if (threadIdx.x == 0) (void)xb_add(&bar[XB_XCNT(b.x)], 1u);
    return b;
}
__device__ __forceinline__ void xcd_barrier_complete(unsigned* bar, unsigned x, unsigned& nloc, unsigned& nx) {
    const unsigned G = gridDim.x * gridDim.y * gridDim.z;
    unsigned sum, cnt, mine, sp = 0u;
    for (;;) {
        sum = 0u; cnt = 0u; mine = 0u;
#pragma unroll
        for (unsigned j = 0; j < 16; ++j) { const unsigned c = xb_ld(&bar[XB_XCNT(j)]); sum += c; cnt += (c > 0u) ? 1u : 0u; mine = (j == x) ? c : mine; }
        if (sum == G) break;
        __builtin_amdgcn_s_sleep(1);
        if ((++sp & 255u) == 0u) { if (xb_ld(&bar[XB_TMO])) break; if (sp > XB_SPIN_CAP) { atomicAdd(&bar[XB_TMO], 1u); break; } }
    }
    nloc = mine > 0u ? mine : 1u; nx = cnt > 0u ? cnt : 1u;
}

__device__ __forceinline__ void xcd_barrier(const XcdBarrier& b) {
    asm volatile("s_waitcnt vmcnt(0)" ::: "memory");
    __syncthreads();
    if (threadIdx.x == 0) {
        unsigned* bar = b.bar;
        __builtin_amdgcn_s_waitcnt(0);
        unsigned nloc = b.st[0], nx = b.st[1];
        if (nloc == 0u) { xcd_barrier_complete(bar, b.x, nloc, nx); b.st[0] = nloc; b.st[1] = nx; }
        const unsigned old = xb_add(&bar[XB_XSUB(b.x)], 1u);
        const unsigned gen = old / nloc;
        if (old + 1u == (gen + 1u) * nloc) {
            __builtin_amdgcn_fence(__ATOMIC_RELEASE, "agent");
            asm volatile("s_waitcnt vmcnt(0)" ::: "memory");
            const unsigned og = xb_add(&bar[XB_TOP], 1u);
            const unsigned tg = og / nx;
            if (og + 1u == (tg + 1u) * nx) xb_add(&bar[XB_TOPGEN], 1u);
            else XB_SPIN(xb_ld(&bar[XB_TOPGEN]) == tg, bar);
            __builtin_amdgcn_fence(__ATOMIC_ACQUIRE, "agent");
            xb_add(&bar[XB_XGEN(b.x)], 1u);
            asm volatile("s_waitcnt vmcnt(0)" ::: "memory");
        } else {
            XB_SPIN(xb_ld(&bar[XB_XGEN(b.x)]) == gen, bar);
            __builtin_amdgcn_fence(__ATOMIC_ACQUIRE, "agent");
            asm volatile("s_waitcnt vmcnt(0)" ::: "memory");
        }
    }
    __syncthreads();
}

typedef unsigned wt_u32x4 __attribute__((ext_vector_type(4)));
typedef float wt_f32x4 __attribute__((ext_vector_type(4)));
__device__ __forceinline__ void st_wt16(void* p, wt_u32x4 v) { asm volatile("global_store_dwordx4 %0, %1, off sc1\n\ts_nop 1" :: "v"(p), "v"(v) : "memory"); }
__device__ __forceinline__ void st_wt16f(void* p, wt_f32x4 v) { asm volatile("global_store_dwordx4 %0, %1, off sc1\n\ts_nop 1" :: "v"(p), "v"(v) : "memory"); }
namespace pg8 {
#define PG8_LAS __attribute__((address_space(3)))
typedef unsigned short bf16_t;
typedef short bf16x8 __attribute__((ext_vector_type(8)));
typedef float f32x4 __attribute__((ext_vector_type(4)));
typedef unsigned u32x4 __attribute__((ext_vector_type(4)));
constexpr int BM = 256, BK = 64, HALF = 128, HTB = HALF * BK * 2  , STAGE_BYTES = 8 * HTB, NXCD = 8, WGM = 8;

__host__ __device__ __forceinline__ int lds_byte(int r, int c) { const int st = (r >> 4) * 2 + (c >> 5), rr = r & 15, cc = c & 31, ob = rr * 64 + cc * 2; return st * 1024 + (ob ^ (((ob >> 9) & 1) << 5)); }
__host__ __device__ __forceinline__ void stage_rc(int b, int& R, int& C) { const int st = b / 1024, sb = b % 1024, swz = sb ^ (((sb >> 9) & 1) << 5); R = (st >> 1) * 16 + swz / 64; C = (st & 1) * 32 + (swz % 64) / 2; }
__host__ __device__ __forceinline__ int perm32(int rho) { const int n = rho >> 4, i = rho & 15; return 8 * (i >> 2) + 4 * n + (i & 3); }

struct Unit { int pm, pn; };
struct Gemm { const bf16_t* A; const bf16_t* Bt; int M, N, K; };

struct StaticOrder {
    int nM, nN, nwg, G, c, base, lim;
    __host__ __device__ void init(int M, int N, int G_, int c_) { nM = M / BM; nN = N / BM; nwg = nM * nN; G = G_; c = c_; base = 0; lim = nwg; }
    __host__ __device__ void window(int b, int l) { base = b; lim = l; }
    __host__ __device__ bool next(int i, Unit& u) const {
        const long L = (long)base + (long)i * G + c; if (L >= lim) return false;
        int wgid = (int)L; { const int q = nwg / NXCD, r = nwg % NXCD, xcd = wgid % NXCD, off = wgid / NXCD; wgid = (xcd < r ? xcd * (q + 1) : r * (q + 1) + (xcd - r) * q) + off; }
        const int nig = WGM * nN, gid = wgid / nig, fm = gid * WGM, gsz = (nM - fm) < WGM ? (nM - fm) : WGM;
        u.pm = fm + ((wgid % nig) % gsz); u.pn = (wgid % nig) / gsz; return true;
    }
    __device__ __forceinline__ void a_ready(const Unit&) const {}
    __device__ __forceinline__ void done(const Unit&) const {}
};

struct ArriveOrder : StaticOrder {
    unsigned* cnt; int first_pn;
    __device__ __forceinline__ void done(const Unit& u) const {
        if (cnt != nullptr && u.pn == first_pn) {
            asm volatile("s_waitcnt vmcnt(0)" ::: "memory");
            if ((threadIdx.x & 63) == 0) __hip_atomic_fetch_add(cnt, 1u, __ATOMIC_RELAXED, __HIP_MEMORY_SCOPE_AGENT);
        }
    }
};

__device__ __forceinline__ unsigned cvt_pk_bf16(float lo, float hi) { unsigned r; asm volatile("v_cvt_pk_bf16_f32 %0, %1, %2" : "=v"(r) : "v"(lo), "v"(hi)); return r; }
typedef unsigned u32x2 __attribute__((ext_vector_type(2)));
constexpr float RMS_EPS = 1e-5f;
__device__ __forceinline__ float silu_f(float g) { return g * __builtin_amdgcn_rcpf(1.0f + __builtin_amdgcn_exp2f(-1.4426950408889634f * g)); }

struct EpiInProj {
    static constexpr bool PERM = false, AFTER_DRAIN = false, MID = false, XPF = false;
    bf16_t *MIX, *QKVG; const float *conv_w, *gain_c; float *SSCT, *HALO, *DEF;
    __device__ __forceinline__ void begin(const Unit& u, PG8_LAS unsigned char* lds) const {}
    __device__ __forceinline__ void mid(f32x4 (&acc)[2][2][4][2], const Unit& u, int wr, int fr, PG8_LAS unsigned char* lds) const {}
    __device__ __forceinline__ void operator()(f32x4 (&acc)[2][2][4][2], const Unit& u, int wr, int wc, int fr, int fq, PG8_LAS unsigned char* lds) const {
        if (u.pn >= 9) {
            const int lane = threadIdx.x & 63, j = u.pn - 9, col = j * 64 + wc * 16 + fq * 4;
            PG8_LAS f32x4* XB = (PG8_LAS f32x4*)(lds + STAGE_BYTES + 2048);
#pragma unroll
            for (int ai = 0; ai < 2; ++ai)
#pragma unroll
                for (int m = 0; m < 4; ++m) acc[ai][0][m][1] *= acc[ai][1][m][0];
            if (fr >= 14) {
#pragma unroll
                for (int ai = 0; ai < 2; ++ai) XB[((2 * ai + wr) * 4 + wc) * 8 + fq * 2 + (fr - 14)] = acc[ai][0][3][1];
                if (wr == 1) st_wt16f(HALO + ((size_t)u.pm * 2 + (fr - 14)) * 1024 + col, acc[1][0][3][1]);
            }
            asm volatile("s_waitcnt lgkmcnt(0)" ::: "memory"); __builtin_amdgcn_s_barrier(); asm volatile("" ::: "memory");
            const f32x4 w0 = *(const f32x4*)(conv_w + col), w1 = *(const f32x4*)(conv_w + 1024 + col), w2 = *(const f32x4*)(conv_w + 2048 + col), gn = *(const f32x4*)(gain_c + col);
            const bool deferred_tile = (u.pm & 7) != 0;
#pragma unroll
            for (int ai = 0; ai < 2; ++ai) {
                const int g = 2 * ai + wr;
                f32x4 prev = (f32x4){0.f, 0.f, 0.f, 0.f};
                if (g >= 1) prev = XB[((g - 1) * 4 + wc) * 8 + fq * 2 + (fr & 1)];
#pragma unroll
                for (int m = 0; m < 4; ++m) {
                    const f32x4 uc = acc[ai][0][m][1], cb = acc[ai][0][m][0], gt = acc[ai][1][m][1];
                    f32x4 v1, v2;
#pragma unroll
                    for (int i = 0; i < 4; ++i) {
                        const float s1 = (fr == 15) ? prev[i] : uc[i], s2 = (fr >= 14) ? prev[i] : uc[i];
                        v1[i] = __int_as_float(__builtin_amdgcn_mov_dpp(__float_as_int(s1), 0x121, 0xf, 0xf, true));
                        v2[i] = __int_as_float(__builtin_amdgcn_mov_dpp(__float_as_int(s2), 0x122, 0xf, 0xf, true));
                    }
                    const f32x4 raw = cb * (w0 * v2 + w1 * v1 + w2 * uc);
                    float ss = (raw[0] * raw[0] + raw[1] * raw[1]) + (raw[2] * raw[2] + raw[3] * raw[3]);
                    ss += __shfl_xor(ss, 16); ss += __shfl_xor(ss, 32);
                    const int rl = ai * HALF + wr * 64 + m * 16 + fr;
                    const bool def = deferred_tile && (rl < 2);
                    if (fq == 0) SSCT[((size_t)u.pm * 64 + j * 4 + wc) * 256 + rl] = def ? 0.f : ss;
                    u32x2 z;
                    z.x = cvt_pk_bf16(raw[0] * gn[0] * silu_f(gt[0]), raw[1] * gn[1] * silu_f(gt[1]));
                    z.y = cvt_pk_bf16(raw[2] * gn[2] * silu_f(gt[2]), raw[3] * gn[3] * silu_f(gt[3]));
                    *(u32x2*)(MIX + (size_t)(u.pm * BM + rl) * 2048 + col) = z;
                    if (def) { float* d = DEF + ((size_t)(u.pm * 2 + rl) * 3) * 1024 + col; st_wt16f(d, cb); st_wt16f(d + 1024, uc); st_wt16f(d + 2048, gt); }
                    prev = uc;
                }
            }
        } else {
            const int row0 = u.pm * BM + wr * 64 + fr;
            const int col = u.pn * 256 + wc * 32 + fq * 8;
            const float qs = (u.pn < 4) ? 0.125f * 1.4426950408889634f : 1.0f;
#pragma unroll
            for (int ai = 0; ai < 2; ++ai)
#pragma unroll
                for (int m = 0; m < 4; ++m) {
                    bf16_t* rowp = QKVG + (size_t)(row0 + ai * HALF + m * 16) * 2304 + col;
#pragma unroll
                    for (int bj = 0; bj < 2; ++bj) {
                        const f32x4 v0 = acc[ai][bj][m][0] * qs, v1 = acc[ai][bj][m][1] * qs;
                        u32x4 w; w.x = cvt_pk_bf16(v0[0], v0[1]); w.y = cvt_pk_bf16(v0[2], v0[3]); w.z = cvt_pk_bf16(v1[0], v1[1]); w.w = cvt_pk_bf16(v1[2], v1[3]);
                        st_wt16(rowp + bj * HALF, w);
                    }
                }
        }
    }
};

struct EpiOut {
    static constexpr bool PERM = false, AFTER_DRAIN = false, MID = true, XPF = false;
    const float* x; float* out; const float* SSC; const float* SSA; float* SSF;
    __device__ __forceinline__ void begin(const Unit& u, PG8_LAS unsigned char* lds) const {
        if (threadIdx.x < 256) { const int row = u.pm * BM + threadIdx.x;
            const float* pc = SSC + (size_t)u.pm * 64 * 256 + threadIdx.x;
            const f32x4 av0 = *(const f32x4*)(SSA + 8 * (size_t)row), av1 = *(const f32x4*)(SSA + 8 * (size_t)row + 4);
            float pv[64];
#pragma unroll
            for (int k = 0; k < 64; ++k) pv[k] = pc[k * 256];
            float c4[4] = {0.f, 0.f, 0.f, 0.f};
#pragma unroll
            for (int k = 0; k < 64; ++k) c4[k & 3] += pv[k];
            const float c = (c4[0] + c4[1]) + (c4[2] + c4[3]);
            const f32x4 av = av0 + av1; const float a = (av[0] + av[1]) + (av[2] + av[3]);
            ((PG8_LAS float*)(lds + STAGE_BYTES))[threadIdx.x] = __builtin_amdgcn_rsqf(c * (1.0f / 1024.0f) + RMS_EPS) * __builtin_amdgcn_sqrtf(a * (1.0f / 1024.0f) + RMS_EPS); }
    }
    __device__ __forceinline__ void mid(f32x4 (&acc)[2][2][4][2], const Unit& u, int wr, int fr, PG8_LAS unsigned char* lds) const {
        const PG8_LAS float* tab = (const PG8_LAS float*)(lds + STAGE_BYTES) + wr * 64 + fr;
#pragma unroll
        for (int ai = 0; ai < 2; ++ai)
#pragma unroll
            for (int m = 0; m < 4; ++m) {
                const float s = tab[ai * HALF + m * 16];
#pragma unroll
                for (int bj = 0; bj < 2; ++bj)
#pragma unroll
                    for (int n = 0; n < 2; ++n) acc[ai][bj][m][n] *= s;
            }
    }
    __device__ __forceinline__ void operator()(f32x4 (&acc)[2][2][4][2], const Unit& u, int wr, int wc, int fr, int fq, PG8_LAS unsigned char* lds) const {
        const int col0 = u.pn * BM + wc * 32 + 4 * fq;
#pragma unroll
        for (int ai = 0; ai < 2; ++ai)
#pragma unroll
            for (int m = 0; m < 4; ++m) {
                const int row = u.pm * BM + ai * HALF + wr * 64 + m * 16 + fr;
                const f32x4 av = *(const f32x4*)(SSA + 8 * (size_t)row) + *(const f32x4*)(SSA + 8 * (size_t)row + 4); const float a = (av[0] + av[1]) + (av[2] + av[3]);
                const float ra = __builtin_amdgcn_rsqf(a * (1.0f / 1024.0f) + RMS_EPS);
                const size_t off = (size_t)row * 1024 + col0;
                float ss = 0.f;
#pragma unroll
                for (int bj = 0; bj < 2; ++bj)
#pragma unroll
                    for (int n = 0; n < 2; ++n) {
                        const f32x4 xv = *(const f32x4*)(x + off + bj * HALF + n * 16);
                        const f32x4 y = xv + acc[ai][bj][m][n] * ra;
                        *(f32x4*)(out + off + bj * HALF + n * 16) = y;
                        ss += (y[0] * y[0] + y[1] * y[1]) + (y[2] * y[2] + y[3] * y[3]);
                    }
                ss += __shfl_xor(ss, 16); ss += __shfl_xor(ss, 32);
                if (fq == 0) SSF[(size_t)row * 16 + u.pn * 4 + wc] = ss;
                asm volatile("" ::: "memory");
            }
    }
};

struct EpiOutFused {
    static constexpr bool PERM = false, AFTER_DRAIN = true, MID = true, XPF = true;
    const float* x; float* out; const float* SSC; const float* SSA; float* SSF; const float* gF; unsigned* pcnt; unsigned* tmo;
    __device__ __forceinline__ void begin(const Unit& u, PG8_LAS unsigned char* lds) const {
        if (threadIdx.x < 256) { const int row = u.pm * BM + threadIdx.x;
            const float* pc = SSC + (size_t)u.pm * 64 * 256 + threadIdx.x;
            const f32x4 av0 = *(const f32x4*)(SSA + 8 * (size_t)row), av1 = *(const f32x4*)(SSA + 8 * (size_t)row + 4);
            float pv[64];
#pragma unroll
            for (int k = 0; k < 64; ++k) pv[k] = pc[k * 256];
            float c4[4] = {0.f, 0.f, 0.f, 0.f};
#pragma unroll
            for (int k = 0; k < 64; ++k) c4[k & 3] += pv[k];
            const float c = (c4[0] + c4[1]) + (c4[2] + c4[3]);
            const f32x4 av = av0 + av1; const float a = (av[0] + av[1]) + (av[2] + av[3]);
            ((PG8_LAS float*)(lds + STAGE_BYTES))[threadIdx.x] = __builtin_amdgcn_rsqf(c * (1.0f / 1024.0f) + RMS_EPS) * __builtin_amdgcn_sqrtf(a * (1.0f / 1024.0f) + RMS_EPS); }
    }
    __device__ __forceinline__ void mid(f32x4 (&acc)[2][2][4][2], const Unit& u, int wr, int fr, PG8_LAS unsigned char* lds) const {
        const PG8_LAS float* tab = (const PG8_LAS float*)(lds + STAGE_BYTES) + wr * 64 + fr;
#pragma unroll
        for (int ai = 0; ai < 2; ++ai)
#pragma unroll
            for (int m = 0; m < 4; ++m) {
                const float s = tab[ai * HALF + m * 16];
#pragma unroll
                for (int bj = 0; bj < 2; ++bj)
#pragma unroll
                    for (int n = 0; n < 2; ++n) acc[ai][bj][m][n] *= s;
            }
    }
    __device__ __forceinline__ void operator()(f32x4 (&acc)[2][2][4][2], const Unit& u, int wr, int wc, int fr, int fq, PG8_LAS unsigned char* lds) const {}
    __device__ __forceinline__ void fused(f32x4 (&acc)[2][2][4][2], const Unit& u, int wr, int wc, int fr, int fq, PG8_LAS unsigned char* lds, int wid, int lane) const {
        const int col0 = u.pn * BM + wc * 32 + 4 * fq;
#pragma unroll
        for (int ai = 0; ai < 2; ++ai) {
            f32x4 xv[4][2][2]; float ra[4];
#pragma unroll
            for (int m = 0; m < 4; ++m) {
                const int row = u.pm * BM + ai * HALF + wr * 64 + m * 16 + fr;
                const size_t off = (size_t)row * 1024 + col0;
                if (ai == 0 && !(wr == 1 && m == 3)) {
                    const int slot_buf = wr ? (m == 0 ? 6 : m == 1 ? 7 : 2) : (m == 0 ? 4 : m == 1 ? 5 : m == 2 ? 0 : 1);
                    const PG8_LAS unsigned char* xb = lds + slot_buf * HTB + (fr >> 1) * 1024 + (fr & 1) * 8192;
#pragma unroll
                    for (int bj = 0; bj < 2; ++bj)
#pragma unroll
                        for (int n = 0; n < 2; ++n) xv[m][bj][n] = *(const PG8_LAS f32x4*)(xb + 16 * ((wc * 8 + fq + bj * 32 + n * 4) ^ fr));
                } else {
#pragma unroll
                for (int bj = 0; bj < 2; ++bj)
#pragma unroll
                    for (int n = 0; n < 2; ++n) xv[m][bj][n] = __builtin_nontemporal_load((const f32x4*)(x + off + bj * HALF + n * 16));
                }
                { const f32x4 av = *(const f32x4*)(SSA + 8 * (size_t)row) + *(const f32x4*)(SSA + 8 * (size_t)row + 4); ra[m] = (av[0] + av[1]) + (av[2] + av[3]); }
            }
#pragma unroll
            for (int m = 0; m < 4; ++m) {
                const int row = u.pm * BM + ai * HALF + wr * 64 + m * 16 + fr;
                const float r = __builtin_amdgcn_rsqf(ra[m] * (1.0f / 1024.0f) + RMS_EPS);
                float ss = 0.f;
#pragma unroll
                for (int bj = 0; bj < 2; ++bj)
#pragma unroll
                    for (int n = 0; n < 2; ++n) {
                        const f32x4 y = xv[m][bj][n] + acc[ai][bj][m][n] * r;
                        acc[ai][bj][m][n] = y;
                        ss += (y[0] * y[0] + y[1] * y[1]) + (y[2] * y[2] + y[3] * y[3]);
                    }
                ss += __shfl_xor(ss, 16); ss += __shfl_xor(ss, 32);
                if (fq == 0) __hip_atomic_store(SSF + (size_t)row * 16 + u.pn * 4 + wc, ss, __ATOMIC_RELAXED, __HIP_MEMORY_SCOPE_AGENT);
            }
            asm volatile("" ::: "memory");
        }
        asm volatile("s_waitcnt vmcnt(0)" ::: "memory");
        __syncthreads();
        if (threadIdx.x == 0) {
            unsigned* pc = pcnt + 64 * u.pm;
            __hip_atomic_fetch_add(pc, 1u, __ATOMIC_RELAXED, __HIP_MEMORY_SCOPE_AGENT);
            unsigned sp = 0;
            while (__hip_atomic_load(pc, __ATOMIC_RELAXED, __HIP_MEMORY_SCOPE_AGENT) < 4u) {
                __builtin_amdgcn_s_sleep(1);
                if ((++sp & 255u) == 0u) { if (xb_ld(tmo)) break; if (sp > XB_SPIN_CAP) { atomicAdd(tmo, 1u); break; } }
            }
            __builtin_amdgcn_fence(__ATOMIC_ACQUIRE, "agent");
            asm volatile("s_waitcnt vmcnt(0)" ::: "memory");
        }
        __syncthreads();
        PG8_LAS float* tab = (PG8_LAS float*)(lds + STAGE_BYTES);
        if (threadIdx.x < 256) { const f32x4* p = (const f32x4*)(SSF + (size_t)(u.pm * BM + threadIdx.x) * 16);
            const f32x4 a = p[0], b = p[1], c = p[2], d = p[3];
            const float s = ((a[0] + a[1]) + (a[2] + a[3])) + ((b[0] + b[1]) + (b[2] + b[3])) + ((c[0] + c[1]) + (c[2] + c[3])) + ((d[0] + d[1]) + (d[2] + d[3]));
            tab[threadIdx.x] = __builtin_amdgcn_rsqf(s * (1.0f / 1024.0f) + RMS_EPS); }
        __syncthreads();
        f32x4 g[2][2];
#pragma unroll
        for (int bj = 0; bj < 2; ++bj)
#pragma unroll
            for (int n = 0; n < 2; ++n) g[bj][n] = *(const f32x4*)(gF + col0 + bj * HALF + n * 16);
#pragma unroll
        for (int ai = 0; ai < 2; ++ai)
#pragma unroll
            for (int m = 0; m < 4; ++m) {
                const int rl = ai * HALF + wr * 64 + m * 16 + fr;
                const float r = tab[rl];
                const size_t off = (size_t)(u.pm * BM + rl) * 1024 + col0;
#pragma unroll
                for (int bj = 0; bj < 2; ++bj)
#pragma unroll
                    for (int n = 0; n < 2; ++n) *(f32x4*)(out + off + bj * HALF + n * 16) = acc[ai][bj][m][n] * r * g[bj][n];
            }
    }
};

template <class Epi, class Sched, bool ALIGN_EPI = false, bool SP2 = false>
__device__ __forceinline__ void gemm_phase(PG8_LAS unsigned char* lds, const Gemm g, const Sched& S, const Epi& E) {
    const int tid = threadIdx.x, wid = __builtin_amdgcn_readfirstlane(tid >> 6), lane = tid & 63, wr = wid >> 2, wc = wid & 3, fr = lane & 15, fq = lane >> 4;
    const int K = g.K, nt = K / BK;
    unsigned voffA[2], voffB[2];
#pragma unroll
    for (int i = 0; i < 2; ++i) { int R, C; stage_rc(tid * 16 + i * 8192, R, C); const int Rb = Epi::PERM ? ((R & ~31) + perm32(R & 31)) : R;
        voffA[i] = (unsigned)(R * K + C) * 2u; voffB[i] = (unsigned)(Rb * K + C) * 2u; }
    unsigned voffX[2] = {0u, 0u};
    if constexpr (Epi::XPF) {
#pragma unroll
        for (int i = 0; i < 2; ++i) { const int rr = 2 * wid + i; voffX[i] = (unsigned)(rr * 1024 + 4 * (lane ^ rr)) * 4u; } }
    const size_t kstep = (size_t)(BK * 2);
    const size_t hstep = (size_t)HALF * K * 2;
    const size_t tstep = 2 * hstep;
    const unsigned ldsw = (unsigned)wid * 1024u;
    const int aoff = lds_byte(wr * 64 + fr, fq * 8), boff = lds_byte(wc * 32 + fr, fq * 8);
#define PG8_SA(b, h) (((b) * 2 + (h)) * HTB)
#define PG8_SB(b, h) ((4 + (b) * 2 + (h)) * HTB)
#define PG8_STAGE(bufoff, gbase, voff) do { _Pragma("unroll") for (int _i = 0; _i < 2; ++_i) \
        __builtin_amdgcn_global_load_lds((const unsigned*)((const char*)(gbase) + (voff)[_i]), (PG8_LAS unsigned*)(lds + (bufoff) + ldsw + _i * 8192), 16, 0, 0); } while (0)
#define PG8_LDA(dst, b, h) do { _Pragma("unroll") for (int m = 0; m < 4; ++m) _Pragma("unroll") for (int k = 0; k < 2; ++k) dst[m][k] = *(const PG8_LAS bf16x8*)(lds + PG8_SA(b, h) + aoff + m * 2048 + k * 1024); } while (0)
#define PG8_LDB(dst, b, h) do { _Pragma("unroll") for (int n = 0; n < 2; ++n) _Pragma("unroll") for (int k = 0; k < 2; ++k) dst[n][k] = *(const PG8_LAS bf16x8*)(lds + PG8_SB(b, h) + boff + n * 2048 + k * 1024); } while (0)
#define PG8_MMA(ai, bj, At, Bt) do { __builtin_amdgcn_s_setprio(1); _Pragma("unroll") for (int m = 0; m < 4; ++m) _Pragma("unroll") for (int n = 0; n < 2; ++n) _Pragma("unroll") for (int k = 0; k < 2; ++k) \
        acc[ai][bj][m][n] = __builtin_amdgcn_mfma_f32_16x16x32_bf16(Bt[n][k], At[m][k], acc[ai][bj][m][n], 0, 0, 0); __builtin_amdgcn_s_setprio(0); } while (0)
#define PG8_WAIT_V(n) asm volatile("s_waitcnt vmcnt(" #n ")" ::: "memory")
#define PG8_WAIT_L(n) asm volatile("s_waitcnt lgkmcnt(" #n ")" ::: "memory")
#define PG8_BAR __builtin_amdgcn_s_barrier()
#define PG8_SCHED __builtin_amdgcn_sched_barrier(0)
    Unit cur, nxt; int ui = 0;
    if (!S.next(0, cur)) return;
    f32x4 acc[2][2][4][2];
#pragma unroll
    for (int a = 0; a < 2; ++a)
#pragma unroll
        for (int b = 0; b < 2; ++b)
#pragma unroll
            for (int m = 0; m < 4; ++m)
#pragma unroll
                for (int n = 0; n < 2; ++n) acc[a][b][m][n] = (f32x4){0.f, 0.f, 0.f, 0.f};
    bf16x8 At[4][2], B0[2][2], B1[2][2];
    const char* cA = (const char*)g.A + (size_t)cur.pm * tstep; const char* cB = (const char*)g.Bt + (size_t)cur.pn * tstep;
    S.a_ready(cur);
    if constexpr (SP2) {
        PG8_STAGE(PG8_SB(0, 0), cB, voffB); PG8_STAGE(PG8_SB(0, 1), cB + hstep, voffB); PG8_STAGE(PG8_SA(0, 0), cA, voffA); PG8_STAGE(PG8_SA(0, 1), cA + hstep, voffA);
        E.begin(cur, lds);
        if (wr == 1) PG8_BAR;
        PG8_WAIT_V(2); PG8_BAR;
        PG8_STAGE(PG8_SB(1, 0), cB + kstep, voffB); PG8_STAGE(PG8_SA(1, 0), cA + kstep, voffA); PG8_STAGE(PG8_SB(1, 1), cB + hstep + kstep, voffB);
        PG8_WAIT_V(6); PG8_BAR;
    } else {
        PG8_STAGE(PG8_SB(0, 0), cB, voffB); PG8_STAGE(PG8_SA(0, 0), cA, voffA); PG8_STAGE(PG8_SB(0, 1), cB + hstep, voffB); PG8_STAGE(PG8_SA(0, 1), cA + hstep, voffA);
        E.begin(cur, lds);
        if (wr == 1) PG8_BAR;
        PG8_WAIT_V(4); PG8_BAR;
        PG8_STAGE(PG8_SB(1, 0), cB + kstep, voffB); PG8_STAGE(PG8_SA(1, 0), cA + kstep, voffA); PG8_STAGE(PG8_SB(1, 1), cB + hstep + kstep, voffB);
        PG8_WAIT_V(6); PG8_BAR;
    }
    for (;;) {
        const bool has_next = S.next(ui + 1, nxt);
        const char* nA = has_next ? (const char*)g.A + (size_t)nxt.pm * tstep : cA; const char* nB = has_next ? (const char*)g.Bt + (size_t)nxt.pn * tstep : cB;
        for (int t = 0; t < nt; t += 2) {
            if constexpr (Epi::MID) { if (t == nt / 2) E.mid(acc, cur, wr, fr, lds); }
            const bool last = (t == nt - 2);
            const char* a1 = cA + (size_t)(t + 1) * kstep;
            const char* a2 = last ? nA : cA + (size_t)(t + 2) * kstep; const char* b2 = last ? nB : cB + (size_t)(t + 2) * kstep;
            const char* a3 = a2 + kstep; const char* b3 = b2 + kstep;
            if (last && has_next) S.a_ready(nxt);
            if constexpr (SP2) {
            PG8_LDB(B0, 0, 0); PG8_LDB(B1, 0, 1); PG8_SCHED; PG8_LDA(At, 0, 0); PG8_STAGE(PG8_SA(1, 1), a1 + hstep, voffA);
            PG8_WAIT_V(8); PG8_WAIT_L(0); PG8_BAR; PG8_MMA(0, 0, At, B0); PG8_MMA(0, 1, At, B1); PG8_BAR; PG8_SCHED;
            if constexpr (Epi::XPF) {
            const bool xsel = last && !has_next;
            const char* xt = (const char*)E.x + ((size_t)cur.pm * BM * 1024 + (size_t)cur.pn * BM) * 4;
            const unsigned vB[2] = {xsel ? voffX[0] : voffB[0], xsel ? voffX[1] : voffB[1]}, vA[2] = {xsel ? voffX[0] : voffA[0], xsel ? voffX[1] : voffA[1]};
#define PG8_XR(s_) (xt + (size_t)((((s_) >> 2) * 64 + ((s_) & 3) * 16)) * 4096)
            PG8_LDA(At, 0, 1); PG8_STAGE(PG8_SB(0, 0), xsel ? PG8_XR(0) : b2, vB); PG8_STAGE(PG8_SB(0, 1), xsel ? PG8_XR(1) : b2 + hstep, vB); PG8_STAGE(PG8_SA(0, 0), xsel ? PG8_XR(2) : a2, vA);
            PG8_WAIT_V(8); PG8_WAIT_L(0); PG8_BAR; PG8_MMA(1, 0, At, B0); PG8_MMA(1, 1, At, B1); PG8_BAR; PG8_SCHED;
            PG8_LDB(B0, 1, 0); PG8_LDB(B1, 1, 1); PG8_SCHED; PG8_LDA(At, 1, 0); PG8_STAGE(PG8_SA(0, 1), xsel ? PG8_XR(3) : a2 + hstep, vA);
            PG8_WAIT_V(8); PG8_WAIT_L(0); PG8_BAR; PG8_MMA(0, 0, At, B0); PG8_MMA(0, 1, At, B1); PG8_BAR; PG8_SCHED;
            PG8_LDA(At, 1, 1); PG8_STAGE(PG8_SB(1, 0), xsel ? PG8_XR(4) : b3, vB); PG8_STAGE(PG8_SB(1, 1), xsel ? PG8_XR(5) : b3 + hstep, vB); PG8_STAGE(PG8_SA(1, 0), xsel ? PG8_XR(6) : a3, vA);
            PG8_WAIT_V(8); PG8_WAIT_L(0); PG8_BAR; PG8_MMA(1, 0, At, B0); PG8_MMA(1, 1, At, B1); PG8_BAR; PG8_SCHED;
#undef PG8_XR
            } else {
            PG8_LDA(At, 0, 1); PG8_STAGE(PG8_SB(0, 0), b2, voffB); PG8_STAGE(PG8_SB(0, 1), b2 + hstep, voffB); PG8_STAGE(PG8_SA(0, 0), a2, voffA);
            PG8_WAIT_V(8); PG8_WAIT_L(0); PG8_BAR; PG8_MMA(1, 0, At, B0); PG8_MMA(1, 1, At, B1); PG8_BAR; PG8_SCHED;
            PG8_LDB(B0, 1, 0); PG8_LDB(B1, 1, 1); PG8_SCHED; PG8_LDA(At, 1, 0); PG8_STAGE(PG8_SA(0, 1), a2 + hstep, voffA);
            PG8_WAIT_V(8); PG8_WAIT_L(0); PG8_BAR; PG8_MMA(0, 0, At, B0); PG8_MMA(0, 1, At, B1); PG8_BAR; PG8_SCHED;
            PG8_LDA(At, 1, 1); PG8_STAGE(PG8_SB(1, 0), b3, voffB); PG8_STAGE(PG8_SB(1, 1), b3 + hstep, voffB); PG8_STAGE(PG8_SA(1, 0), a3, voffA);
            PG8_WAIT_V(8); PG8_WAIT_L(0); PG8_BAR; PG8_MMA(1, 0, At, B0); PG8_MMA(1, 1, At, B1); PG8_BAR; PG8_SCHED;
            }
            } else {
            PG8_LDB(B0, 0, 0); PG8_SCHED; PG8_LDA(At, 0, 0); PG8_STAGE(PG8_SA(1, 1), a1 + hstep, voffA);
            PG8_WAIT_L(8); PG8_BAR; PG8_WAIT_L(0); PG8_MMA(0, 0, At, B0); PG8_BAR; PG8_SCHED;
            PG8_LDB(B1, 0, 1); PG8_STAGE(PG8_SB(0, 0), b2, voffB);
            PG8_BAR; PG8_WAIT_L(0); PG8_MMA(0, 1, At, B1); PG8_BAR;
            PG8_LDA(At, 0, 1); PG8_STAGE(PG8_SA(0, 0), a2, voffA);
            PG8_BAR; PG8_WAIT_L(0); PG8_MMA(1, 0, At, B0); PG8_BAR; PG8_SCHED;
            PG8_STAGE(PG8_SB(0, 1), b2 + hstep, voffB);
            PG8_WAIT_V(6); PG8_BAR; PG8_MMA(1, 1, At, B1); PG8_BAR;
            PG8_LDB(B0, 1, 0); PG8_SCHED; PG8_LDA(At, 1, 0); PG8_STAGE(PG8_SA(0, 1), a2 + hstep, voffA);
            PG8_WAIT_L(8); PG8_BAR; PG8_WAIT_L(0); PG8_MMA(0, 0, At, B0); PG8_BAR; PG8_SCHED;
            PG8_LDB(B1, 1, 1); PG8_STAGE(PG8_SB(1, 0), b3, voffB);
            PG8_BAR; PG8_WAIT_L(0); PG8_MMA(0, 1, At, B1); PG8_BAR;
            PG8_LDA(At, 1, 1); PG8_STAGE(PG8_SA(1, 0), a3, voffA);
            PG8_BAR; PG8_WAIT_L(0); PG8_MMA(1, 0, At, B0); PG8_BAR; PG8_SCHED;
            PG8_STAGE(PG8_SB(1, 1), b3 + hstep, voffB);
            PG8_WAIT_V(6); PG8_BAR; PG8_MMA(1, 1, At, B1); PG8_BAR;
            }
        }
        if constexpr (ALIGN_EPI) { if (wr == 0) PG8_BAR; }
        if constexpr (!Epi::AFTER_DRAIN) { E(acc, cur, wr, wc, fr, fq, lds); S.done(cur); }
        if (!has_next) break;
#pragma unroll
        for (int a = 0; a < 2; ++a)
#pragma unroll
            for (int b = 0; b < 2; ++b)
#pragma unroll
                for (int m = 0; m < 4; ++m)
#pragma unroll
                    for (int n = 0; n < 2; ++n) acc[a][b][m][n] = (f32x4){0.f, 0.f, 0.f, 0.f};
        cur = nxt; cA = nA; cB = nB; ++ui;
        E.begin(cur, lds);
        if constexpr (ALIGN_EPI) { if (wr == 1) PG8_BAR; }
    }
    PG8_WAIT_V(0);
    if constexpr (!ALIGN_EPI) { if (wr == 0) PG8_BAR; }
    PG8_BAR;
    if constexpr (Epi::AFTER_DRAIN) { E.fused(acc, cur, wr, wc, fr, fq, lds, wid, lane); S.done(cur); }
#undef PG8_SA
#undef PG8_SB
#undef PG8_STAGE
#undef PG8_LDA
#undef PG8_LDB
#undef PG8_MMA
#undef PG8_WAIT_V
#undef PG8_WAIT_L
#undef PG8_BAR
#undef PG8_SCHED
}
}
constexpr int M = 16384, DM = 1024, NPROJ = 6400, DMIX = 2048, SEQ = 2048;
constexpr int QP = 2304;
constexpr size_t MiB = 1u << 20;
constexpr size_t WS_SSA = 9 * MiB, WS_SSF = 512 * 1024;
constexpr size_t WS_WOUT = 2 * MiB;
constexpr size_t WS_HALO = 6 * MiB;
constexpr size_t WS_DEF = 7 * MiB;
constexpr size_t WS_WIN = 10 * MiB;
constexpr size_t WS_XN = 24 * MiB;
constexpr size_t WS_MIX = 56 * MiB;
constexpr size_t WS_QKVG = 120 * MiB;
constexpr size_t WS_SSC = 192 * MiB;
constexpr size_t WS_END = 196 * MiB;
constexpr int NWAVES = 8;
constexpr int LDS_BYTES = 147456;
typedef unsigned short bf16;
typedef unsigned v4u __attribute__((ext_vector_type(4)));
typedef unsigned v2u __attribute__((ext_vector_type(2)));
typedef float f32x4 __attribute__((ext_vector_type(4)));
typedef float f32x16 __attribute__((ext_vector_type(16)));
typedef short bf16x8 __attribute__((ext_vector_type(8)));
typedef short s16x4 __attribute__((ext_vector_type(4)));
#define LDS_WAIT() asm volatile("s_waitcnt lgkmcnt(0)" ::: "memory")
__device__ __forceinline__ unsigned pk2(float lo, float hi) { return pg8::cvt_pk_bf16(lo, hi); }
__device__ __forceinline__ float bflo(unsigned w) { return __uint_as_float(w << 16); }
__device__ __forceinline__ float bfhi(unsigned w) { return __uint_as_float(w & 0xffff0000u); }
__device__ __forceinline__ float wave_sum(float v) {
#pragma unroll
    for (int o = 1; o < 64; o <<= 1) v += __shfl_xor(v, o);
    return v;
}
__device__ __forceinline__ float silu(float g) { return g * __builtin_amdgcn_rcpf(1.0f + __builtin_amdgcn_exp2f(-1.4426950408889634f * g)); }

__device__ __forceinline__ int win_dst_row(int n) {
    if (n < 4096) { const int s = n >> 10, jc = n & 1023, j = jc >> 6, ch = jc & 63, wc = ch >> 4, fq = (ch >> 2) & 3, i = ch & 3, bj = s >> 1, nn = s & 1;
        return 2304 + 256 * j + 128 * bj + 32 * wc + 16 * nn + 4 * fq + i; }
    const int a = n - 4096, pn = a >> 8, lg = a & 255, bj = lg >> 7, wc = (lg >> 5) & 3, fq = (lg >> 3) & 3, nn = (lg >> 2) & 1, i = lg & 3;
    return 256 * pn + 128 * bj + 32 * wc + 16 * nn + 4 * fq + i;
}
template <bool PERMUTE>
__device__ __forceinline__ void p0_transpose_item(const float* W, int K, int N, bf16* WT, LAS float* scr, int item, int lane) {
    const int nblk = N / 32, kb = item / nblk, nb = item % nblk, k0 = 64 * kb, n0 = 32 * nb;
    float wv[32];
#pragma unroll
    for (int i = 0; i < 32; ++i) wv[i] = __builtin_nontemporal_load(W + (size_t)(k0 + 2 * i + (lane >> 5)) * N + n0 + (lane & 31));
#pragma unroll
    for (int i = 0; i < 32; ++i) scr[(2 * i + (lane >> 5)) * 33 + (lane & 31)] = wv[i];
    LDS_WAIT(); asm volatile("" ::: "memory");
    const int c = lane & 7;
#pragma unroll
    for (int j = 0; j < 4; ++j) { const int n = (lane >> 3) + 8 * j; const LAS float* s = scr + (8 * c) * 33 + n;
        v4u o; o.x = pk2(s[0 * 33], s[1 * 33]); o.y = pk2(s[2 * 33], s[3 * 33]); o.z = pk2(s[4 * 33], s[5 * 33]); o.w = pk2(s[6 * 33], s[7 * 33]);
        const int dr = PERMUTE ? win_dst_row(n0 + n) : (n0 + n);
        if (PERMUTE && n0 < 4096) __builtin_nontemporal_store(o, (v4u*)(WT + (size_t)dr * K + k0 + 8 * c));
        else *(v4u*)(WT + (size_t)dr * K + k0 + 8 * c) = o; }
    LDS_WAIT(); asm volatile("" ::: "memory");
}
__device__ __forceinline__ void rms_row_to_bf16(const float* xrow, const float* g, bf16* orow, int lane) {
    const f32x4* xr = (const f32x4*)xrow + lane; const f32x4* gr = (const f32x4*)g + lane;
    f32x4 v[4]; float s = 0.f;
#pragma unroll
    for (int j = 0; j < 4; ++j) { v[j] = xr[64 * j]; s += (v[j].x * v[j].x + v[j].y * v[j].y) + (v[j].z * v[j].z + v[j].w * v[j].w); }
    const float rstd = __builtin_amdgcn_rsqf(wave_sum(s) * (1.f / DM) + pg8::RMS_EPS);
    unsigned long long* o8 = (unsigned long long*)orow + lane;
#pragma unroll
    for (int j = 0; j < 4; ++j) { const f32x4 gg = gr[64 * j]; const f32x4 y = v[j] * rstd * gg;
        o8[64 * j] = (unsigned long long)pk2(y.x, y.y) | ((unsigned long long)pk2(y.z, y.w) << 32); }
}

__device__ __forceinline__ void rms_rows4_to_bf16(const float* xrow, const float* g, bf16* orow, int lane) {
    f32x4 v[4][4]; float s[4];
#pragma unroll
    for (int r = 0; r < 4; ++r) { const f32x4* xr = (const f32x4*)(xrow + (size_t)r * DM) + lane;
#pragma unroll
        for (int j = 0; j < 4; ++j) v[r][j] = __builtin_nontemporal_load(xr + 64 * j); }
#pragma unroll
    for (int r = 0; r < 4; ++r) { float t = 0.f;
#pragma unroll
        for (int j = 0; j < 4; ++j) t += (v[r][j].x * v[r][j].x + v[r][j].y * v[r][j].y) + (v[r][j].z * v[r][j].z + v[r][j].w * v[r][j].w);
        s[r] = t; }
#pragma unroll
    for (int o = 1; o < 64; o <<= 1) {
#pragma unroll
        for (int r = 0; r < 4; ++r) s[r] += __shfl_xor(s[r], o); }
    const f32x4* gr = (const f32x4*)g + lane;
#pragma unroll
    for (int r = 0; r < 4; ++r) { const float rstd = __builtin_amdgcn_rsqf(s[r] * (1.f / DM) + pg8::RMS_EPS);
        unsigned long long* o8 = (unsigned long long*)(orow + (size_t)r * DM) + lane;
#pragma unroll
        for (int j = 0; j < 4; ++j) { const f32x4 y = v[r][j] * rstd * gr[64 * j];
            o8[64 * j] = (unsigned long long)pk2(y.x, y.y) | ((unsigned long long)pk2(y.z, y.w) << 32); } }
}

constexpr int KP = 72, VP = 264;
constexpr int LDS_KS = 0, LDS_VT = 256 * KP * 2, LDS_SS = LDS_VT + 64 * VP * 2, LDS_WT = LDS_SS + 4096 + 2048;
__device__ __forceinline__ void attn_unit(LAS unsigned char* lds, int unit, int mode, const bf16* QKVG, const float* sinks, const float* gain_a, bf16* MIX, float* SSA) {
    const int tid = threadIdx.x, lane = tid & 63, w = __builtin_amdgcn_readfirstlane(tid >> 6);
    const int kvh = unit & 1, blk = unit >> 1, nblk = blk & 15, T0 = blk * 128;
    const int hl = (mode == 0 || mode >= 3) ? w : (4 * (mode - 1) + (w & 3));
    const int i0 = (mode == 0) ? 0 : (mode <= 2) ? 2 * (w >> 2) : (mode - 3), i1 = (mode == 0) ? 4 : (mode <= 2) ? i0 + 2 : i0 + 1;
    LAS bf16* Ks = (LAS bf16*)(lds + LDS_KS); LAS bf16* Vt = (LAS bf16*)(lds + LDS_VT); LAS float* SS = (LAS float*)(lds + LDS_SS);
    const int h = kvh * 8 + hl, q = lane & 31, hh = lane >> 5;
    SS[tid] = 0.f; SS[tid + 512] = 0.f;
    const int r8 = lane >> 3, c8 = lane & 7;
    const bf16* qrow0 = QKVG + (size_t)(T0 + r8) * QP + h * 64 + 8 * c8;
    const bf16* grow0 = qrow0 + 1280;
    LAS bf16* WT = (LAS bf16*)(lds + LDS_WT) + w * (32 * KP);
    LAS bf16* wt_row = WT + r8 * KP + 8 * c8;
    LAS bf16* wt_frq = WT + q * KP + 8 * hh;
    LAS bf16* wt_frd = WT + q * KP + 4 * hh;
    bf16x8 qr[4]; v2u gt[8]; v4u qrow[4], grow[4];
#pragma unroll
    for (int k = 0; k < 4; ++k) qrow[k] = __builtin_nontemporal_load((const v4u*)(qrow0 + (size_t)(32 * i0 + 8 * k) * QP));
    if (mode < 3 || tid < 320) {
        const int rp = ((mode >= 3) ? 16 * (mode - 3) : 0) + (tid >> 2), qd = tid & 3, row = 2 * rp;
        const bool valid = (nblk > 0) || (row >= 128);
        const int tok = valid ? (T0 - 128 + row) : T0;
        const bf16* src = QKVG + (size_t)tok * QP + 1024 + kvh * 64 + qd * 16;
        v4u k0[2], k1[2], v0[2], v1[2];
#pragma unroll
        for (int c = 0; c < 2; ++c) { k0[c] = *(const v4u*)(src + 8 * c); k1[c] = *(const v4u*)(src + QP + 8 * c); v0[c] = *(const v4u*)(src + 128 + 8 * c); v1[c] = *(const v4u*)(src + QP + 128 + 8 * c);
            if (!valid) { k0[c] = k1[c] = v0[c] = v1[c] = (v4u){0u, 0u, 0u, 0u}; } }
#pragma unroll
        for (int c = 0; c < 2; ++c) { *(LAS v4u*)(Ks + row * KP + qd * 16 + 8 * c) = k0[c]; *(LAS v4u*)(Ks + (row + 1) * KP + qd * 16 + 8 * c) = k1[c]; }
        const int kq = row & 15, pos = (row & ~15) + (kq & 3) + 4 * ((kq >> 3) & 1) + 8 * ((kq >> 2) & 1);
#pragma unroll
        for (int c = 0; c < 2; ++c)
#pragma unroll
            for (int e = 0; e < 4; ++e) { const unsigned a = v0[c][e], b = v1[c][e];
                *(LAS unsigned*)(Vt + (qd * 16 + 8 * c + 2 * e) * VP + pos) = (a & 0xffffu) | (b << 16);
                *(LAS unsigned*)(Vt + (qd * 16 + 8 * c + 2 * e + 1) * VP + pos) = (a >> 16) | (b & 0xffff0000u); }
    }
    __syncthreads();
    constexpr float LOG2E = 1.4426950408889634f;
    const float slope2 = exp2f(-0.5f * (float)(h + 1)) * LOG2E, sink2 = sinks[h] * LOG2E;
    LAS float* GN = SS + 8 * 128 + w * 64;
    GN[lane] = gain_a[h * 64 + lane];
#pragma unroll
    for (int k = 0; k < 4; ++k) *(LAS v4u*)(wt_row + 8 * k * KP) = qrow[k];
#pragma unroll
    for (int s = 0; s < 4; ++s) qr[s] = *(const LAS bf16x8*)(wt_frq + 16 * s);
    for (int i = i0; i < i1; ++i) {
        const int inx = (i < 3) ? (i + 1) : 3;
#pragma unroll
        for (int k = 0; k < 4; ++k) qrow[k] = __builtin_nontemporal_load((const v4u*)(qrow0 + (size_t)(32 * inx + 8 * k) * QP));
#pragma unroll
        for (int k = 0; k < 4; ++k) grow[k] = __builtin_nontemporal_load((const v4u*)(grow0 + (size_t)(32 * i + 8 * k) * QP));
        int qq = q - 4 * hh; asm volatile("" : "+v"(qq));
        float base = slope2 * (float)(4 * hh); asm volatile("" : "+v"(base));
        f32x16 st[5];
#pragma unroll
        for (int j = 0; j < 5; ++j) {
            const bool tile_ok = !(nblk == 0 && (i + j) < 4);
            const float sl = tile_ok ? slope2 : 0.f, bs = tile_ok ? base : -INFINITY;
#pragma unroll
            for (int r = 0; r < 16; ++r) st[j][r] = fmaf(sl, (float)((r & 3) + 8 * (r >> 2) + 32 * j), bs);
        }
        {
            const LAS bf16* kp = Ks + (32 * i + q) * KP + hh * 8;
            bf16x8 kf[2][5];
#pragma unroll
            for (int j = 0; j < 5; ++j) kf[0][j] = *(const LAS bf16x8*)(kp + j * 32 * KP);
#pragma unroll
            for (int s = 0; s < 4; ++s) {
                if (s < 3) {
#pragma unroll
                    for (int j = 0; j < 5; ++j) kf[(s + 1) & 1][j] = *(const LAS bf16x8*)(kp + j * 32 * KP + 16 * (s + 1));
                }
#pragma unroll
                for (int j = 0; j < 5; ++j) st[j] = __builtin_amdgcn_mfma_f32_32x32x16_bf16(kf[s & 1][j], qr[s], st[j], 0, 0, 0);
            }
        }
        const float sinkq = fmaf(slope2, (float)(128 + 4 * hh) + (float)qq, sink2);
        float mx = sinkq;
#pragma unroll
        for (int r = 0; r < 16; ++r) {
            const int cr = (r & 3) + 8 * (r >> 2);
            const bool up = cr > qq;
            st[0][r] = up ? st[0][r] : -INFINITY;
            st[4][r] = up ? -INFINITY : st[4][r];
        }
#pragma unroll
        for (int j = 0; j < 5; ++j)
#pragma unroll
            for (int r = 0; r < 16; ++r) mx = fmaxf(mx, st[j][r]);
        mx = fmaxf(mx, __shfl_xor(mx, 32));
        float sum = 0.f;
#pragma unroll
        for (int j = 0; j < 5; ++j)
#pragma unroll
            for (int r = 0; r < 16; ++r) { const float p = __builtin_amdgcn_exp2f(st[j][r] - mx); st[j][r] = p; sum += p; }
        sum += __shfl_xor(sum, 32);
        sum += __builtin_amdgcn_exp2f(sinkq - mx);
        const float inv = __builtin_amdgcn_rcpf(sum);
        f32x16 ot[2]; ot[0] = f32x16{}; ot[1] = f32x16{};
#pragma unroll
        for (int j = 0; j < 5; ++j)
#pragma unroll
            for (int s2 = 0; s2 < 2; ++s2) {
                v4u pw; pw.x = pk2(st[j][8 * s2 + 0], st[j][8 * s2 + 1]); pw.y = pk2(st[j][8 * s2 + 2], st[j][8 * s2 + 3]);
                pw.z = pk2(st[j][8 * s2 + 4], st[j][8 * s2 + 5]); pw.w = pk2(st[j][8 * s2 + 6], st[j][8 * s2 + 7]);
                const bf16x8 pf = __builtin_bit_cast(bf16x8, pw);
#pragma unroll
                for (int db = 0; db < 2; ++db) {
                    const bf16x8 vf = *(const LAS bf16x8*)(Vt + (db * 32 + q) * VP + 32 * (i + j) + 16 * s2 + 8 * hh);
                    ot[db] = __builtin_amdgcn_mfma_f32_32x32x16_bf16(vf, pf, ot[db], 0, 0, 0);
                }
            }
        float ss = 0.f;
#pragma unroll
        for (int k = 0; k < 4; ++k) *(LAS v4u*)(wt_row + 8 * k * KP) = grow[k];
#pragma unroll
        for (int e = 0; e < 8; ++e) gt[e] = *(const LAS v2u*)(wt_frd + 32 * (e >> 2) + 8 * (e & 3));
#pragma unroll
        for (int e = 0; e < 8; ++e) {
            const int db = e >> 2, g4 = e & 3;
            const float o0 = ot[db][4 * g4 + 0] * inv, o1 = ot[db][4 * g4 + 1] * inv, o2 = ot[db][4 * g4 + 2] * inv, o3 = ot[db][4 * g4 + 3] * inv;
            ss += (o0 * o0 + o1 * o1) + (o2 * o2 + o3 * o3);
            const f32x4 gn = *(const LAS f32x4*)(GN + 4 * hh + 32 * db + 8 * g4);
            v2u z; z.x = pk2(o0 * gn[0] * silu(bflo(gt[e].x)), o1 * gn[1] * silu(bfhi(gt[e].x)));
            z.y = pk2(o2 * gn[2] * silu(bflo(gt[e].y)), o3 * gn[3] * silu(bfhi(gt[e].y)));
            *(LAS v2u*)(wt_frd + 32 * db + 8 * g4) = z;
        }
        {
            bf16* orow0 = MIX + (size_t)(T0 + 32 * i + r8) * DMIX + 1024 + h * 64 + 8 * c8;
#pragma unroll
            for (int k = 0; k < 4; ++k) { const v4u v = *(const LAS v4u*)(wt_row + 8 * k * KP); *(v4u*)(orow0 + (size_t)(8 * k) * DMIX) = v; }
        }
#pragma unroll
        for (int k = 0; k < 4; ++k) *(LAS v4u*)(wt_row + 8 * k * KP) = qrow[k];
        ss += __shfl_xor(ss, 32);
        if (hh == 0) SS[w * 128 + 32 * i + q] = ss;
#pragma unroll
        for (int s = 0; s < 4; ++s) qr[s] = *(const LAS bf16x8*)(wt_frq + 16 * s);
    }
    __syncthreads();
    if (tid < 128) { float s = 0.f;
#pragma unroll
        for (int ww = 0; ww < 8; ++ww) s += SS[ww * 128 + tid];
        float* sa = SSA + (size_t)(T0 + tid) * 8 + kvh * 4;
        if (mode == 0) *(f32x4*)sa = (f32x4){s, 0.f, 0.f, 0.f};
        else if (mode <= 2) { sa[2 * (mode - 1)] = s; sa[2 * (mode - 1) + 1] = 0.f; }
        else if ((tid >> 5) == mode - 3) *(f32x4*)sa = (f32x4){s, 0.f, 0.f, 0.f}; }
    __syncthreads();
}

__device__ __forceinline__ void conv_fixup(int idx, int lane, const float* DEF, const float* HALO, const float* conv_w, const float* gain_c, bf16* MIX, float* SSC) {
    const int pm = idx >> 1, rho = idx & 1;
    if ((pm & 7) == 0) return;
    const int c = lane * 16, t = pm * 256 + rho;
    const float* d = DEF + ((size_t)(pm * 2 + rho) * 3) * 1024 + c;
    const float* p1 = rho ? (DEF + ((size_t)(pm * 2) * 3 + 1) * 1024 + c) : (HALO + ((size_t)(pm - 1) * 2 + 1) * 1024 + c);
    const float* p2 = rho ? (HALO + ((size_t)(pm - 1) * 2 + 1) * 1024 + c) : (HALO + ((size_t)(pm - 1) * 2) * 1024 + c);
    float ss = 0.f; unsigned zw[8];
#pragma unroll
    for (int e4 = 0; e4 < 4; ++e4) {
        const f32x4 cb = *(const f32x4*)(d + 4 * e4), u0 = *(const f32x4*)(d + 1024 + 4 * e4), g = *(const f32x4*)(d + 2048 + 4 * e4), u1 = *(const f32x4*)(p1 + 4 * e4), u2 = *(const f32x4*)(p2 + 4 * e4);
        const f32x4 w0 = *(const f32x4*)(conv_w + c + 4 * e4), w1 = *(const f32x4*)(conv_w + 1024 + c + 4 * e4), w2 = *(const f32x4*)(conv_w + 2048 + c + 4 * e4), gn = *(const f32x4*)(gain_c + c + 4 * e4);
        const f32x4 raw = cb * (w0 * u2 + w1 * u1 + w2 * u0);
        ss += (raw[0] * raw[0] + raw[1] * raw[1]) + (raw[2] * raw[2] + raw[3] * raw[3]);
        zw[2 * e4] = pk2(raw[0] * gn[0] * silu(g[0]), raw[1] * gn[1] * silu(g[1])); zw[2 * e4 + 1] = pk2(raw[2] * gn[2] * silu(g[2]), raw[3] * gn[3] * silu(g[3]));
    }
    *(v4u*)(MIX + (size_t)t * DMIX + c) = (v4u){zw[0], zw[1], zw[2], zw[3]}; *(v4u*)(MIX + (size_t)t * DMIX + c + 8) = (v4u){zw[4], zw[5], zw[6], zw[7]};
    ss = wave_sum(ss); if (lane == 0) SSC[(size_t)pm * 64 * 256 + rho] = ss;
}

__device__ __forceinline__ void group_arrive(unsigned* cnt) {
    asm volatile("s_waitcnt vmcnt(0)" ::: "memory");
    __syncthreads();
    if (threadIdx.x == 0) __hip_atomic_fetch_add(cnt, 1u, __ATOMIC_RELAXED, __HIP_MEMORY_SCOPE_AGENT);
}
__device__ __forceinline__ void group_wait(unsigned* cnt, unsigned want, unsigned* bar) {
    if (threadIdx.x == 0) {
        unsigned sp = 0;
        while (__hip_atomic_load(cnt, __ATOMIC_RELAXED, __HIP_MEMORY_SCOPE_AGENT) < want) {
            __builtin_amdgcn_s_sleep(2);
            if ((++sp & 255u) == 0u) { if (xb_ld(&bar[XB_TMO])) break; if (sp > XB_SPIN_CAP) { atomicAdd(&bar[XB_TMO], 1u); break; } }
        }
        __builtin_amdgcn_fence(__ATOMIC_ACQUIRE, "agent");
        asm volatile("s_waitcnt vmcnt(0)" ::: "memory");
    }
    __syncthreads();
}

constexpr size_t WS_BAR = 1536 * 1024;
constexpr int LDS_TAB = 131072, LDS_MISC = LDS_TAB + 1024;
struct Args { const float *x, *norm_in, *w_in, *conv_w, *sinks, *norm_conv, *norm_attn, *w_out, *norm_final; float* out; unsigned char* ws; int use_cg; int pad; };
__global__ void __launch_bounds__(NWAVES * 64, 2) fwd_megakernel(Args a) {
    extern __shared__ __attribute__((aligned(16))) unsigned char lds_raw[];
    LAS unsigned char* lds = (LAS unsigned char*)lds_raw;
    const int tid = threadIdx.x, lane = tid & 63, wave = __builtin_amdgcn_readfirstlane(tid >> 6);
    const int G = gridDim.x, gw = blockIdx.x * NWAVES + wave, NGW = G * NWAVES;
    unsigned char* ws = a.ws;
    float* SSC = (float*)(ws + WS_SSC); float* SSA = (float*)(ws + WS_SSA); float* SSF = (float*)(ws + WS_SSF);
    bf16* WOUT = (bf16*)(ws + WS_WOUT); bf16* WIN = (bf16*)(ws + WS_WIN); bf16* XN = (bf16*)(ws + WS_XN); bf16* MIX = (bf16*)(ws + WS_MIX);
    bf16* QKVG = (bf16*)(ws + WS_QKVG); float* HALO = (float*)(ws + WS_HALO); float* DEF = (float*)(ws + WS_DEF);
    if (a.use_cg) cg::this_grid().sync();
    volatile LAS unsigned* MISC = (volatile LAS unsigned*)(lds + LDS_MISC);
    if (tid < 32) MISC[tid] = 0u;
    __syncthreads();
    const XcdBarrier bar = xcd_barrier_post((unsigned*)(ws + WS_BAR), MISC + 8);

    {
        LAS float* scr = (LAS float*)(lds + wave * 16384);
        constexpr int I_IN = (DM / 64) * (NPROJ / 32);
        if (G == 256) {
            { const int kb = gw >> 7, nb = gw & 127; p0_transpose_item<true>(a.w_in, DM, NPROJ, WIN, scr, kb * (NPROJ / 32) + nb, lane); }
            if (gw < 1152) { const int kb = gw / 72, nb = 128 + gw % 72; p0_transpose_item<true>(a.w_in, DM, NPROJ, WIN, scr, kb * (NPROJ / 32) + nb, lane); }
        } else
        for (int it = gw; it < I_IN; it += NGW) p0_transpose_item<true>(a.w_in, DM, NPROJ, WIN, scr, it, lane);
        for (int m = gw * 4; m < M; m += NGW * 4) rms_rows4_to_bf16(a.x + (size_t)m * DM, a.norm_in, XN + (size_t)m * DM, lane);
    }
    xcd_barrier(bar);
    {
        pg8::Gemm g{XN, WIN, M, NPROJ, DM}; pg8::ArriveOrder S; S.init(M, NPROJ, G, (int)blockIdx.x);
        pg8::EpiInProj E{MIX, QKVG, a.conv_w, a.norm_conv, SSC, HALO, DEF};
        const bool flow = (G == 256);
        unsigned* gca = (unsigned*)(ws + WS_BAR) + 4096 + 64 * (blockIdx.x & 7);
        unsigned* gcc = (unsigned*)(ws + WS_BAR) + 8192 + 64 * (blockIdx.x & 7);
        S.cnt = flow ? gca : nullptr; S.first_pn = (blockIdx.x < 64) ? 12 : 8 + (int)(blockIdx.x >> 6);
        pg8::gemm_phase<pg8::EpiInProj, pg8::ArriveOrder, true, true>(lds, g, S, E);
        if (flow) {
            group_arrive(gcc);
            const int gb = blockIdx.x & 7, l = blockIdx.x >> 3;
            if (l >= 8) {
                group_wait(gca, 256u, (unsigned*)(ws + WS_BAR));
                attn_unit(lds, gb * 32 + l, 0, QKVG, a.sinks, a.norm_attn, MIX, SSA);
                {
                    LAS float* scr = (LAS float*)(lds + wave * 16384);
                    constexpr int I_OUT = (DMIX / 64) * (DM / 32);
                    const int it = ((blockIdx.x & 7) * 24 + (l - 8)) * NWAVES + wave;
                    if (it < I_OUT) p0_transpose_item<false>(a.w_out, DMIX, DM, WOUT, scr, it, lane);
                    __syncthreads();
                }
            } else group_wait(gca, 256u, (unsigned*)(ws + WS_BAR));
            attn_unit(lds, gb * 32 + (l >> 2), 3 + (l & 3), QKVG, a.sinks, a.norm_attn, MIX, SSA);
            if (l >= 24) {
                group_wait(gcc, 32u, (unsigned*)(ws + WS_BAR));
                if (l != 24 && wave < 2) conv_fixup(2 * (gb * 8 + (l - 24)) + wave, lane, DEF, HALO, a.conv_w, a.norm_conv, MIX, SSC);
            }
        } else {
            xcd_barrier(bar);
            for (int unit = blockIdx.x; unit < 256; unit += G) attn_unit(lds, unit, 0, QKVG, a.sinks, a.norm_attn, MIX, SSA);
            for (int idx = gw; idx < 128; idx += NGW) conv_fixup(idx, lane, DEF, HALO, a.conv_w, a.norm_conv, MIX, SSC);
            LAS float* scr = (LAS float*)(lds + wave * 16384);
            constexpr int I_OUT = (DMIX / 64) * (DM / 32);
            for (int it = gw; it < I_OUT; it += NGW) p0_transpose_item<false>(a.w_out, DMIX, DM, WOUT, scr, it, lane);
        }
    }
    xcd_barrier(bar);
    if (G == 256) {
        pg8::Gemm g{MIX, WOUT, M, DM, DMIX}; pg8::StaticOrder S; S.init(M, DM, G, (int)blockIdx.x);
        pg8::EpiOutFused E{a.x, a.out, SSC, SSA, SSF, a.norm_final, (unsigned*)(ws + WS_BAR) + 12288, (unsigned*)(ws + WS_BAR) + XB_TMO};
        pg8::gemm_phase<pg8::EpiOutFused, pg8::StaticOrder, false, true>(lds, g, S, E);
    } else {
        {
            pg8::Gemm g{MIX, WOUT, M, DM, DMIX}; pg8::StaticOrder S; S.init(M, DM, G, (int)blockIdx.x);
            pg8::EpiOut E{a.x, a.out, SSC, SSA, SSF};
            pg8::gemm_phase<pg8::EpiOut, pg8::StaticOrder, true, true>(lds, g, S, E);
        }
        xcd_barrier(bar);
        for (int m = gw; m < M; m += NGW) {
            float s = SSF[(size_t)m * 16 + (lane & 15)];
            s += __shfl_xor(s, 1); s += __shfl_xor(s, 2); s += __shfl_xor(s, 4); s += __shfl_xor(s, 8);
            const float rstd = __builtin_amdgcn_rsqf(s * (1.f / DM) + pg8::RMS_EPS);
            f32x4* o = (f32x4*)(a.out + (size_t)m * DM) + lane; const f32x4* gf = (const f32x4*)a.norm_final + lane;
#pragma unroll
            for (int j = 0; j < 4; ++j) o[64 * j] = o[64 * j] * rstd * gf[64 * j];
        }
    }
}

extern "C" void kernel_launch(void* const* d_in, const int* in_sizes, int n_in, void* d_out, int out_size, void* d_ws, size_t ws_size, hipStream_t stream) {
    static int grid = 0;
    if (grid == 0) {
        if (n_in != 9 || in_sizes[0] != M * DM || out_size != M * DM || ws_size < WS_END) { fprintf(stderr, "kernel_launch: unexpected shapes (n_in %d in0 %d out %d ws %zu)\n", n_in, n_in > 0 ? in_sizes[0] : -1, out_size, ws_size); grid = -1; return; }
        int dev = 0, cus = 0, per_cu = 0;
        (void)hipGetDevice(&dev); (void)hipDeviceGetAttribute(&cus, hipDeviceAttributeMultiprocessorCount, dev);
        if (hipFuncSetAttribute((const void*)fwd_megakernel, hipFuncAttributeMaxDynamicSharedMemorySize, LDS_BYTES) != hipSuccess) { fprintf(stderr, "kernel_launch: hipFuncSetAttribute failed\n"); grid = -1; return; }
        if (hipOccupancyMaxActiveBlocksPerMultiprocessor(&per_cu, (const void*)fwd_megakernel, NWAVES * 64, LDS_BYTES) != hipSuccess || per_cu < 1) { fprintf(stderr, "kernel_launch: occupancy query says %d\n", per_cu); per_cu = 1; }
        (void)hipGetLastError();
        grid = cus * 1;
    }
    if (grid < 0) return;
    (void)hipMemsetAsync((unsigned char*)d_ws + WS_BAR, 0, 65536, stream);
    Args a{};
    a.x = (const float*)d_in[0]; a.norm_in = (const float*)d_in[1]; a.w_in = (const float*)d_in[2]; a.conv_w = (const float*)d_in[3]; a.sinks = (const float*)d_in[4];
    a.norm_conv = (const float*)d_in[5]; a.norm_attn = (const float*)d_in[6]; a.w_out = (const float*)d_in[7]; a.norm_final = (const float*)d_in[8];
    a.out = (float*)d_out; a.ws = (unsigned char*)d_ws; a.use_cg = 0; a.pad = 0;
    void* args[] = {&a};
    hipError_t e = hipLaunchCooperativeKernel((const void*)fwd_megakernel, dim3(grid), dim3(NWAVES * 64), args, LDS_BYTES, stream);
    if (e != hipSuccess) fprintf(stderr, "cooperative launch failed: %s (grid %d)\n", hipGetErrorString(e), grid);
}
```
